# Optimizing an MI355X kernel written in HIP

```python
import math
import jax, jax.numpy as jnp
from jax import lax
import numpy as np

D_MODEL = 1024
BATCH = 8
SEQ = 2048
DEPTH = 1
DEC_BATCH = 128
DEC_SEQ = 8
PAST_LEN = 2048
PAGE_SIZE = 128

N_DIFF_HEADS = 4
DIFF_HEAD_DIM = 64
DIFF_V_DIM = 2 * DIFF_HEAD_DIM
ATTN_WIDTH = N_DIFF_HEADS * DIFF_V_DIM
POOL_WINDOWS = (2, 4, 8, 16)
N_POOL_GROUPS = len(POOL_WINDOWS)
POOL_GROUP_DIM = 64
POOL_WIDTH = N_POOL_GROUPS * POOL_GROUP_DIM
POOL_STATE = max(POOL_WINDOWS) - 1
N_MEM_HEADS = 4
MEM_HEAD_DIM = 64
MEM_WIDTH = N_MEM_HEADS * MEM_HEAD_DIM
N_MEM = 256
N_BRANCHES = 3
D_FF = 2816
CONV_WIDTH = 3
N_BUCKETS = 32
MAX_DISTANCE = 128
Q_BLOCK = 128
EPS = 1e-6
NEG_INF = -1e30
IN_SIZES = (N_DIFF_HEADS * 2 * DIFF_HEAD_DIM, N_DIFF_HEADS * 2 * DIFF_HEAD_DIM, ATTN_WIDTH,
            POOL_WIDTH, MEM_WIDTH, N_BRANCHES * D_MODEL)
D_IN = sum(IN_SIZES)
IN_SPLITS = tuple(int(s) for s in np.cumsum(IN_SIZES)[:-1])

kernel_name = 'hybrid_diffattn_pool_memxattn_convffn_step'


def rmsnorm(x, g):
    xf = x.astype(jnp.float32)
    y = xf * lax.rsqrt(jnp.mean(xf * xf, axis=-1, keepdims=True) + EPS)
    return (y * g.astype(jnp.float32)).astype(x.dtype)


def lambda_init(layer_idx):
    return 0.8 - 0.6 * math.exp(-0.3 * layer_idx)


def rel_bucket(rel):
    n = jnp.maximum(rel, 0)
    max_exact = N_BUCKETS // 2
    nf = jnp.maximum(n, 1).astype(jnp.float32)
    large = max_exact + (jnp.log(nf / max_exact) / math.log(MAX_DISTANCE / max_exact)
                         * (N_BUCKETS - max_exact)).astype(jnp.int32)
    large = jnp.minimum(large, N_BUCKETS - 1)
    return jnp.where(n < max_exact, n, large)


def diff_attn_block(qb, qpos_b, k, v, k_pos, rel_bias, lam):
    s = jnp.einsum('bqhcd,bkhcd->bchqk', qb.astype(jnp.float32), k.astype(jnp.float32)) * (DIFF_HEAD_DIM ** -0.5)
    rel = qpos_b[:, None] - k_pos[None, :]
    bias = jnp.transpose(rel_bias.astype(jnp.float32)[rel_bucket(rel)], (2, 0, 1))
    s = jnp.where(rel[None, None, None] >= 0, s + bias[None, None], NEG_INF)
    p = jax.nn.softmax(s, axis=-1)
    a = p[:, 0] - lam * p[:, 1]
    return jnp.einsum('bhqk,bkhe->bqhe', a, v.astype(jnp.float32))


def diff_attention(q, k, v, q_pos, k_pos, rel_bias, lam):
    B, Q = q.shape[0], q.shape[1]
    blk = Q_BLOCK if Q % Q_BLOCK == 0 else Q
    nb = Q // blk
    qb = jnp.moveaxis(q.reshape(B, nb, blk, N_DIFF_HEADS, 2, DIFF_HEAD_DIM), 1, 0)
    pb = q_pos.reshape(nb, blk)
    out = lax.map(lambda a: diff_attn_block(a[0], a[1], k, v, k_pos, rel_bias, lam), (qb, pb))
    return jnp.moveaxis(out, 0, 1).reshape(B, Q, N_DIFF_HEADS, DIFF_V_DIM)


def pool_mixer(u, prefix, pos, w_grp, scale):
    B, L, _ = u.shape
    P = prefix.shape[1]
    ext = jnp.concatenate([prefix, u], axis=1)
    c = jnp.pad(jnp.cumsum(ext.astype(jnp.float32), axis=1), ((0, 0), (1, 0), (0, 0)))
    means = []
    for gi, w in enumerate(POOL_WINDOWS):
        sl = slice(gi * POOL_GROUP_DIM, (gi + 1) * POOL_GROUP_DIM)
        win_sum = c[:, P + 1:P + 1 + L, sl] - c[:, P + 1 - w:P + 1 - w + L, sl]
        cnt = jnp.minimum(pos + 1, w).astype(jnp.float32)[None, :, None]
        means.append(win_sum / cnt)
    d = (jnp.concatenate(means, axis=-1) - u.astype(jnp.float32)).reshape(B, L, N_POOL_GROUPS, POOL_GROUP_DIM)
    y = jnp.einsum('blgc,gcd->blgd', d, w_grp.astype(jnp.float32)).reshape(B, L, POOL_WIDTH)
    y = y * scale.astype(jnp.float32)
    return y.astype(u.dtype), ext[:, ext.shape[1] - P:]


def mem_kv(mem, g, w):
    Bm, M, _ = mem.shape
    k, v = jnp.split(rmsnorm(mem, g) @ w, 2, axis=-1)
    return (k.reshape(Bm, M, N_MEM_HEADS, MEM_HEAD_DIM), v.reshape(Bm, M, N_MEM_HEADS, MEM_HEAD_DIM))


def conv_ffn(h, prefix, w_gate, w_up, conv_w, conv_b, w_down):
    L = h.shape[1]
    g = h @ w_gate
    u = h @ w_up
    ext = jnp.concatenate([prefix, g], axis=1)
    gc = conv_b
    for j in range(CONV_WIDTH):
        gc = gc + conv_w[j] * ext[:, j:j + L]
    f = (jax.nn.gelu(gc) * u) @ w_down
    return f, ext[:, ext.shape[1] - (CONV_WIDTH - 1):]


def layer(x, pos, k_past, v_past, k_pos, pool_prefix, conv_prefix, mem_k, mem_v, prm, rel_bias, lam_init):
    (norm1_g, w_in, lam_q1, lam_k1, lam_q2, lam_k2, subln_g, w_pool_grp, pool_scale,
     w_br_attn, w_br_pool, w_br_mem, w_out, norm2_g, w_ffn_gate, w_ffn_up,
     ffn_conv_w, ffn_conv_b, w_ffn_down) = prm
    B, L, _ = x.shape
    h = rmsnorm(x, norm1_g)
    q, k, v, u, qm, gl = jnp.split(h @ w_in, IN_SPLITS, axis=-1)
    q = q.reshape(B, L, N_DIFF_HEADS, 2, DIFF_HEAD_DIM)
    k = k.reshape(B, L, N_DIFF_HEADS, 2 * DIFF_HEAD_DIM)
    v = v.reshape(B, L, N_DIFF_HEADS, DIFF_V_DIM)
    k_all = k if k_past is None else jnp.concatenate([k_past.astype(k.dtype), k], axis=1)
    v_all = v if v_past is None else jnp.concatenate([v_past.astype(v.dtype), v], axis=1)
    K = k_all.shape[1]
    f32 = jnp.float32
    lam = (jnp.exp(jnp.sum(lam_q1.astype(f32) * lam_k1.astype(f32)))
           - jnp.exp(jnp.sum(lam_q2.astype(f32) * lam_k2.astype(f32))) + lam_init)
    o = diff_attention(q, k_all.reshape(B, K, N_DIFF_HEADS, 2, DIFF_HEAD_DIM), v_all, pos, k_pos, rel_bias, lam)
    o = (rmsnorm(o, subln_g) * (1.0 - lam_init)).astype(x.dtype).reshape(B, L, ATTN_WIDTH)
    pool_out, pool_state = pool_mixer(u, pool_prefix.astype(u.dtype), pos, w_pool_grp, pool_scale)
    qm = qm.reshape(B, L, N_MEM_HEADS, MEM_HEAD_DIM)
    sm = jnp.einsum('bqhd,bmhd->bhqm', qm.astype(f32), mem_k.astype(f32)) * (MEM_HEAD_DIM ** -0.5)
    pm = jax.nn.softmax(sm, axis=-1)
    om = jnp.einsum('bhqm,bmhd->bqhd', pm, mem_v.astype(f32)).astype(x.dtype).reshape(B, L, MEM_WIDTH)
    ga, gb, gm = jnp.split(jax.nn.sigmoid(gl), N_BRANCHES, axis=-1)
    merged = ga * (o @ w_br_attn) + gb * (pool_out @ w_br_pool) + gm * (om @ w_br_mem)
    x = x + merged @ w_out
    f, conv_state = conv_ffn(rmsnorm(x, norm2_g), conv_prefix.astype(x.dtype), w_ffn_gate, w_ffn_up,
                             ffn_conv_w, ffn_conv_b, w_ffn_down)
    x = x + f
    return x, k, v, pool_state, conv_state


def setup_inputs(seed: int = 0) -> dict:
    key = jax.random.key(seed)
    ks = jax.random.split(key, 40)
    n_pages = PAST_LEN // PAGE_SIZE
    n_phys = (DEC_BATCH * n_pages * 5) // 4
    nrm = lambda i, shape, s=1.0: jax.random.normal(ks[i], shape, jnp.float32) * s
    gain = lambda i, shape: 1.0 + 0.02 * jax.random.normal(ks[i], shape, jnp.float32)
    kv_shape = (DEPTH, n_phys, PAGE_SIZE, N_DIFF_HEADS, 2 * DIFF_HEAD_DIM)
    page_table = jax.random.permutation(ks[5], n_phys)[:DEC_BATCH * n_pages].reshape(DEC_BATCH, n_pages).astype(jnp.int32)
    return {
        'x_prompt': nrm(0, (BATCH, SEQ, D_MODEL)),
        'x_sample': nrm(1, (DEC_BATCH, DEC_SEQ, D_MODEL)),
        'mem_prompt': nrm(2, (BATCH, N_MEM, D_MODEL)),
        'cache_k': nrm(3, kv_shape),
        'cache_v': nrm(4, kv_shape),
        'page_table': page_table,
        'state_pool': nrm(6, (DEPTH, DEC_BATCH, POOL_STATE, POOL_WIDTH)),
        'state_ffn_conv': nrm(7, (DEPTH, DEC_BATCH, CONV_WIDTH - 1, D_FF)),
        'cache_mem_k': nrm(8, (DEPTH, DEC_BATCH, N_MEM, N_MEM_HEADS, MEM_HEAD_DIM)),
        'cache_mem_v': nrm(9, (DEPTH, DEC_BATCH, N_MEM, N_MEM_HEADS, MEM_HEAD_DIM)),
        'norm1_g': gain(10, (DEPTH, D_MODEL)),
        'w_in': nrm(11, (DEPTH, D_MODEL, D_IN), D_MODEL ** -0.5),
        'lam_q1': nrm(12, (DEPTH, DIFF_HEAD_DIM), 0.1),
        'lam_k1': nrm(13, (DEPTH, DIFF_HEAD_DIM), 0.1),
        'lam_q2': nrm(14, (DEPTH, DIFF_HEAD_DIM), 0.1),
        'lam_k2': nrm(15, (DEPTH, DIFF_HEAD_DIM), 0.1),
        'subln_g': gain(16, (DEPTH, DIFF_V_DIM)),
        'w_pool_grp': nrm(17, (DEPTH, N_POOL_GROUPS, POOL_GROUP_DIM, POOL_GROUP_DIM), POOL_GROUP_DIM ** -0.5),
        'pool_scale': 1.0 + 0.1 * nrm(18, (DEPTH, POOL_WIDTH)),
        'w_br_attn': nrm(19, (DEPTH, ATTN_WIDTH, D_MODEL), ATTN_WIDTH ** -0.5),
        'w_br_pool': nrm(20, (DEPTH, POOL_WIDTH, D_MODEL), POOL_WIDTH ** -0.5),
        'w_br_mem': nrm(21, (DEPTH, MEM_WIDTH, D_MODEL), MEM_WIDTH ** -0.5),
        'mem_norm_g': gain(22, (DEPTH, D_MODEL)),
        'w_mem_kv': nrm(23, (DEPTH, D_MODEL, 2 * MEM_WIDTH), D_MODEL ** -0.5),
        'w_out': nrm(24, (DEPTH, D_MODEL, D_MODEL), D_MODEL ** -0.5),
        'norm2_g': gain(25, (DEPTH, D_MODEL)),
        'w_ffn_gate': nrm(26, (DEPTH, D_MODEL, D_FF), D_MODEL ** -0.5),
        'w_ffn_up': nrm(27, (DEPTH, D_MODEL, D_FF), D_MODEL ** -0.5),
        'ffn_conv_w': nrm(28, (DEPTH, CONV_WIDTH, D_FF), CONV_WIDTH ** -0.5),
        'ffn_conv_b': nrm(29, (DEPTH, D_FF), 0.01),
        'w_ffn_down': nrm(30, (DEPTH, D_FF, D_MODEL), D_FF ** -0.5),
        'rel_bias': nrm(31, (N_BUCKETS, N_DIFF_HEADS), 0.5),
        'final_norm_g': gain(32, (D_MODEL,)),
    }


def reference(x_prompt, x_sample, mem_prompt, cache_k, cache_v, page_table, state_pool, state_ffn_conv,
              cache_mem_k, cache_mem_v, norm1_g, w_in, lam_q1, lam_k1, lam_q2, lam_k2, subln_g,
              w_pool_grp, pool_scale, w_br_attn, w_br_pool, w_br_mem, mem_norm_g, w_mem_kv, w_out,
              norm2_g, w_ffn_gate, w_ffn_up, ffn_conv_w, ffn_conv_b, w_ffn_down, rel_bias, final_norm_g):
    B, S, _ = x_prompt.shape
    DB, DS, _ = x_sample.shape
    n_pages = page_table.shape[1]
    page = cache_k.shape[2]
    past = n_pages * page
    pos_p = jnp.arange(S, dtype=jnp.int32)
    pos_s = past + jnp.arange(DS, dtype=jnp.int32)
    kpos_s = jnp.arange(past + DS, dtype=jnp.int32)
    xp, xs = x_prompt, x_sample
    kp_l, vp_l, ks_l, vs_l, poolp_l, pools_l, convp_l, convs_l, mkp_l, mvp_l = ([] for _ in range(10))
    for l in range(DEPTH):
        lam_init = lambda_init(l)
        prm = (norm1_g[l], w_in[l], lam_q1[l], lam_k1[l], lam_q2[l], lam_k2[l], subln_g[l], w_pool_grp[l],
               pool_scale[l], w_br_attn[l], w_br_pool[l], w_br_mem[l], w_out[l], norm2_g[l], w_ffn_gate[l],
               w_ffn_up[l], ffn_conv_w[l], ffn_conv_b[l], w_ffn_down[l])
        mk_p, mv_p = mem_kv(mem_prompt, mem_norm_g[l], w_mem_kv[l])
        pool0 = jnp.zeros((B, POOL_STATE, POOL_WIDTH), xp.dtype)
        conv0 = jnp.zeros((B, CONV_WIDTH - 1, D_FF), xp.dtype)
        xp, kp, vp, poolp, convp = layer(xp, pos_p, None, None, pos_p, pool0, conv0, mk_p, mv_p,
                                         prm, rel_bias, lam_init)
        k_past = cache_k[l][page_table].reshape(DB, past, N_DIFF_HEADS, 2 * DIFF_HEAD_DIM)
        v_past = cache_v[l][page_table].reshape(DB, past, N_DIFF_HEADS, DIFF_V_DIM)
        xs, ks_, vs_, pools, convs = layer(xs, pos_s, k_past, v_past, kpos_s, state_pool[l], state_ffn_conv[l],
                                           cache_mem_k[l], cache_mem_v[l], prm, rel_bias, lam_init)
        kp_l.append(kp); vp_l.append(vp); ks_l.append(ks_); vs_l.append(vs_)
        poolp_l.append(poolp); pools_l.append(pools); convp_l.append(convp); convs_l.append(convs)
        mkp_l.append(mk_p); mvp_l.append(mv_p)
    y_prompt = rmsnorm(xp, final_norm_g)
    y_sample = rmsnorm(xs, final_norm_g)
    return (y_prompt, y_sample, jnp.stack(kp_l), jnp.stack(vp_l), jnp.stack(ks_l), jnp.stack(vs_l),
            jnp.stack(poolp_l), jnp.stack(pools_l), jnp.stack(convp_l), jnp.stack(convs_l),
            jnp.stack(mkp_l), jnp.stack(mvp_l))
```

```cpp
#include <hip/hip_runtime.h>
#include <cstdio>
#include <cstdint>

#define LAS __attribute__((address_space(3)))
#define GAS __attribute__((address_space(1)))
typedef unsigned short bf16;
typedef short bf16x8 __attribute__((ext_vector_type(8)));
typedef short s16x4 __attribute__((ext_vector_type(4)));
typedef float f32x4 __attribute__((ext_vector_type(4)));
typedef float f32x2 __attribute__((ext_vector_type(2)));
typedef unsigned u32x4 __attribute__((ext_vector_type(4)));
typedef unsigned u32x2 __attribute__((ext_vector_type(2)));
typedef GAS unsigned gu32;

constexpr int D = 1024, MP = 16384, MS = 1024, MT = MP + MS, MM = 2048, MA = MT + MM;
constexpr int SEQ = 2048, NB = 8, DB = 128, DS = 8, NPAGES = 16;
constexpr int DFF = 2816, NW1 = 5632, NGU = 5632;
constexpr float EPS = 1e-6f, LOG2E = 1.4426950408889634f, QSCALE = 0.125f * 1.4426950408889634f, NEGB = -1e30f;
constexpr float LAM_INIT = 0.2f;
constexpr size_t O_YP = 0, O_YS = 16777216, O_KP = 17825792, O_VP = 26214400, O_KS = 34603008, O_VS = 35127296,
                 O_POOLP = 35651584, O_POOLS = 35682304, O_CONVP = 36173824, O_CONVS = 36218880, O_MK = 36939776, O_MV = 37464064, O_END = 37988352;
constexpr size_t MiB = 1u << 20;
constexpr size_t WS_CTL = 0, CTL_ZERO_BYTES = 1 * MiB;
constexpr size_t WS_W1T = 2 * MiB, WS_WBR = 13 * MiB, WS_WOUT = 15 * MiB, WS_WGU = 17 * MiB, WS_WD = 28 * MiB;
constexpr size_t WS_XN = 34 * MiB, WS_QB = 72 * MiB, WS_KB = 89 * MiB, WS_VB = 106 * MiB, WS_QMB = 123 * MiB, WS_U = 132 * MiB, WS_G = 149 * MiB;
constexpr size_t WS_MKB = 251 * MiB, WS_MVB = 252 * MiB, WS_BR = 253 * MiB, WS_TMP = 287 * MiB, WS_MG = 355 * MiB, WS_X1 = 389 * MiB, WS_A2 = 457 * MiB;
constexpr size_t WS_SS = 491 * MiB, WS_GG = 493 * MiB, WS_UU = 587 * MiB, WS_ACT = 681 * MiB, WS_X2 = 775 * MiB, WS_END = 843 * MiB;
constexpr int CW_BAR = 4096;

__device__ __forceinline__ unsigned pk2(float lo, float hi) { unsigned r; asm("v_cvt_pk_bf16_f32 %0, %1, %2" : "=v"(r) : "v"(lo), "v"(hi)); return r; }
__device__ __forceinline__ float bflo(unsigned w) { return __builtin_bit_cast(float, w << 16); }
__device__ __forceinline__ float bfhi(unsigned w) { return __builtin_bit_cast(float, w & 0xffff0000u); }
template <int CTRL> __device__ __forceinline__ float dppx(float v) { return __builtin_bit_cast(float, __builtin_amdgcn_update_dpp(0, __builtin_bit_cast(int, v), CTRL, 0xf, 0xf, true)); }
#define SWAP16(v, a, b) unsigned a = __builtin_bit_cast(unsigned, v), b = a; asm("" : "+v"(b)); { auto r_ = __builtin_amdgcn_permlane16_swap(a, b, false, false); a = r_[0]; b = r_[1]; }
#define SWAP32(v, a, b) unsigned a = __builtin_bit_cast(unsigned, v), b = a; asm("" : "+v"(b)); { auto r_ = __builtin_amdgcn_permlane32_swap(a, b, false, false); a = r_[0]; b = r_[1]; }
__device__ __forceinline__ float sum16(float v) { SWAP16(v, a, b); return __builtin_bit_cast(float, a) + __builtin_bit_cast(float, b); }
__device__ __forceinline__ float sum32(float v) { SWAP32(v, a, b); return __builtin_bit_cast(float, a) + __builtin_bit_cast(float, b); }
__device__ __forceinline__ float max16(float v) { SWAP16(v, a, b); return fmaxf(__builtin_bit_cast(float, a), __builtin_bit_cast(float, b)); }
__device__ __forceinline__ float max32(float v) { SWAP32(v, a, b); return fmaxf(__builtin_bit_cast(float, a), __builtin_bit_cast(float, b)); }
__device__ __forceinline__ float sum_g4(float v) { return sum32(sum16(v)); }
__device__ __forceinline__ float max_g4(float v) { return max32(max16(v)); }
__device__ __forceinline__ float wave_sum(float v) {
    v += dppx<0xB1>(v); v += dppx<0x4E>(v); v += dppx<0x141>(v); v += dppx<0x140>(v);
    return sum_g4(v);
}
__device__ __forceinline__ float fexp2(float x) { return __builtin_amdgcn_exp2f(x); }
__device__ __forceinline__ float frcp(float x) { return __builtin_amdgcn_rcpf(x); }
__device__ __forceinline__ float frsq(float x) { return __builtin_amdgcn_rsqf(x); }

namespace pg8 {
constexpr int BM = 256, BK = 64, HALF = 128, HTB = HALF * BK * 2, STAGE_BYTES = 8 * HTB, NXCD = 8, WGM = 8;
__host__ __device__ __forceinline__ int lds_byte(int r, int c) { const int st = (r >> 4) * 2 + (c >> 5), rr = r & 15, cc = c & 31, ob = rr * 64 + cc * 2; return st * 1024 + (ob ^ (((ob >> 9) & 1) << 5)); }
__host__ __device__ __forceinline__ void stage_rc(int b, int& R, int& C) { const int st = b / 1024, sb = b % 1024, swz = sb ^ (((sb >> 9) & 1) << 5); R = (st >> 1) * 16 + swz / 64; C = (st & 1) * 32 + (swz % 64) / 2; }
__host__ __device__ __forceinline__ int perm32(int rho) { const int n = rho >> 4, i = rho & 15; return 8 * (i >> 2) + 4 * n + (i & 3); }

struct Unit { int pm, pn; };
struct Gemm { const bf16* A; const bf16* Bt; int K, lda, ldb; };

struct StaticOrder {
    int nM, nN, nwg, G, c;
    __device__ void init(int M, int N, int G_, int c_) { nM = M / BM; nN = N / BM; nwg = nM * nN; G = G_; c = c_; }
    __device__ bool next(int i, Unit& u) const {
        const long L = (long)i * G + c; if (L >= nwg) return false;
        int wgid = (int)L; { const int q = nwg / NXCD, r = nwg % NXCD, xcd = wgid % NXCD, off = wgid / NXCD; wgid = (xcd < r ? xcd * (q + 1) : r * (q + 1) + (xcd - r) * q) + off; }
        const int nig = WGM * nN, gid = wgid / nig, fm = gid * WGM, gsz = (nM - fm) < WGM ? (nM - fm) : WGM;
        u.pm = fm + ((wgid % nig) % gsz); u.pn = (wgid % nig) / gsz; return true;
    }
    __device__ __forceinline__ void a_ready(const Unit&) const {}
    __device__ __forceinline__ void done(const Unit&) const {}
};
struct Order1 {
    StaticOrder so; int G, c;
    __device__ void init(int G_, int c_) { so.init(MT, 5120, G_, c_); G = G_; c = c_; }
    __device__ bool next(int i, Unit& u) const {
        const long L = (long)i * G + c;
        if (L < so.nwg) return so.next(i, u);
        const int e = (int)(L - so.nwg); if (e >= 16) return false;
        u.pm = 68 + (e >> 1); u.pn = 20 + (e & 1); return true;
    }
    __device__ __forceinline__ void a_ready(const Unit&) const {}
    __device__ __forceinline__ void done(const Unit&) const {}
};

template <class Epi, class Sched>
__device__ __forceinline__ void gemm_phase(LAS unsigned char* lds, const Gemm g, const Sched& S, const Epi& E, const int tid) {
    const int wid = __builtin_amdgcn_readfirstlane(tid >> 6), lane = tid & 63, wr = wid >> 2, wc = wid & 3, fr = lane & 15, fq = lane >> 4;
    const int K = g.K, nt = K / BK;
    unsigned voffA[2], voffB[2];
#pragma unroll
    for (int i = 0; i < 2; ++i) { int R, C; stage_rc(tid * 16 + i * 8192, R, C); const int Rb = Epi::PERM ? ((R & ~31) + perm32(R & 31)) : R;
        voffA[i] = (unsigned)(R * g.lda + C) * 2u; voffB[i] = (unsigned)(Rb * g.ldb + C) * 2u; }
    const size_t kstep = (size_t)(BK * 2);
    const size_t hstepA = (size_t)HALF * g.lda * 2, hstepB = (size_t)HALF * g.ldb * 2;
    const size_t tstepA = 2 * hstepA, tstepB = 2 * hstepB;
    const unsigned ldsw = (unsigned)wid * 1024u;
    const int aoff = lds_byte(wr * 64 + fr, fq * 8), boff = lds_byte(wc * 32 + fr, fq * 8);
#define PG8_SA(b, h) (((b) * 2 + (h)) * HTB)
#define PG8_SB(b, h) ((4 + (b) * 2 + (h)) * HTB)
#define PG8_STAGE(bufoff, gbase, voff) do { _Pragma("unroll") for (int _i = 0; _i < 2; ++_i) \
        __builtin_amdgcn_global_load_lds((const unsigned*)((const char*)(gbase) + (voff)[_i]), (LAS unsigned*)(lds + (bufoff) + ldsw + _i * 8192), 16, 0, 0); } while (0)
#define PG8_LDA(dst, b, h) do { _Pragma("unroll") for (int m = 0; m < 4; ++m) _Pragma("unroll") for (int k = 0; k < 2; ++k) dst[m][k] = *(const LAS bf16x8*)(lds + PG8_SA(b, h) + aoff + m * 2048 + k * 1024); } while (0)
#define PG8_LDB(dst, b, h) do { _Pragma("unroll") for (int n = 0; n < 2; ++n) _Pragma("unroll") for (int k = 0; k < 2; ++k) dst[n][k] = *(const LAS bf16x8*)(lds + PG8_SB(b, h) + boff + n * 2048 + k * 1024); } while (0)
#define PG8_MMA(ai, bj, At, Bt) do { __builtin_amdgcn_s_setprio(1); _Pragma("unroll") for (int m = 0; m < 4; ++m) _Pragma("unroll") for (int n = 0; n < 2; ++n) _Pragma("unroll") for (int k = 0; k < 2; ++k) \
        acc[ai][bj][m][n] = __builtin_amdgcn_mfma_f32_16x16x32_bf16(Bt[n][k], At[m][k], acc[ai][bj][m][n], 0, 0, 0); __builtin_amdgcn_s_setprio(0); } while (0)
#define PG8_WAIT_V(n) asm volatile("s_waitcnt vmcnt(" #n ")" ::: "memory")
#define PG8_WAIT_L(n) asm volatile("s_waitcnt lgkmcnt(" #n ")" ::: "memory")
#define PG8_BAR __builtin_amdgcn_s_barrier()
#define PG8_SCHED __builtin_amdgcn_sched_barrier(0)
    Unit cur, nxt; int ui = 0;
    if (!S.next(0, cur)) return;
    f32x4 acc[2][2][4][2];
#pragma unroll
    for (int a = 0; a < 2; ++a)
#pragma unroll
        for (int b = 0; b < 2; ++b)
#pragma unroll
            for (int m = 0; m < 4; ++m)
#pragma unroll
                for (int n = 0; n < 2; ++n) acc[a][b][m][n] = (f32x4){0.f, 0.f, 0.f, 0.f};
    bf16x8 At[4][2], B0[2][2], B1[2][2];
    const char* cA = (const char*)g.A + (size_t)cur.pm * tstepA; const char* cB = (const char*)g.Bt + (size_t)cur.pn * tstepB;
    S.a_ready(cur);
    PG8_STAGE(PG8_SB(0, 0), cB, voffB); PG8_STAGE(PG8_SB(0, 1), cB + hstepB, voffB); PG8_STAGE(PG8_SA(0, 0), cA, voffA); PG8_STAGE(PG8_SA(0, 1), cA + hstepA, voffA);
    if (wr == 1) PG8_BAR;
    PG8_WAIT_V(2); PG8_BAR;
    PG8_STAGE(PG8_SB(1, 0), cB + kstep, voffB); PG8_STAGE(PG8_SA(1, 0), cA + kstep, voffA); PG8_STAGE(PG8_SB(1, 1), cB + hstepB + kstep, voffB);
    PG8_WAIT_V(6); PG8_BAR;
    for (;;) {
        const bool has_next = S.next(ui + 1, nxt);
        const char* nA = has_next ? (const char*)g.A + (size_t)nxt.pm * tstepA : cA; const char* nB = has_next ? (const char*)g.Bt + (size_t)nxt.pn * tstepB : cB;
        for (int t = 0; t < nt; t += 2) {
            const bool last = (t == nt - 2);
            const char* a1 = cA + (size_t)(t + 1) * kstep;
            const char* a2 = last ? nA : cA + (size_t)(t + 2) * kstep; const char* b2 = last ? nB : cB + (size_t)(t + 2) * kstep;
            const char* a3 = a2 + kstep; const char* b3 = b2 + kstep;
            if (last && has_next) S.a_ready(nxt);
            PG8_LDB(B0, 0, 0); PG8_LDB(B1, 0, 1); PG8_SCHED; PG8_LDA(At, 0, 0); PG8_STAGE(PG8_SA(1, 1), a1 + hstepA, voffA);
            PG8_WAIT_V(8); PG8_WAIT_L(0); PG8_BAR; PG8_MMA(0, 0, At, B0); PG8_MMA(0, 1, At, B1); PG8_BAR; PG8_SCHED;
            PG8_LDA(At, 0, 1); PG8_STAGE(PG8_SB(0, 0), b2, voffB); PG8_STAGE(PG8_SB(0, 1), b2 + hstepB, voffB); PG8_STAGE(PG8_SA(0, 0), a2, voffA);
            PG8_WAIT_V(8); PG8_WAIT_L(0); PG8_BAR; PG8_MMA(1, 0, At, B0); PG8_MMA(1, 1, At, B1); PG8_BAR; PG8_SCHED;
            PG8_LDB(B0, 1, 0); PG8_LDB(B1, 1, 1); PG8_SCHED; PG8_LDA(At, 1, 0); PG8_STAGE(PG8_SA(0, 1), a2 + hstepA, voffA);
            PG8_WAIT_V(8); PG8_WAIT_L(0); PG8_BAR; PG8_MMA(0, 0, At, B0); PG8_MMA(0, 1, At, B1); PG8_BAR; PG8_SCHED;
            PG8_LDA(At, 1, 1); PG8_STAGE(PG8_SB(1, 0), b3, voffB); PG8_STAGE(PG8_SB(1, 1), b3 + hstepB, voffB); PG8_STAGE(PG8_SA(1, 0), a3, voffA);
            PG8_WAIT_V(8); PG8_WAIT_L(0); PG8_BAR; PG8_MMA(1, 0, At, B0); PG8_MMA(1, 1, At, B1); PG8_BAR; PG8_SCHED;
        }
        if (wr == 0) PG8_BAR;
        E(acc, cur, wr, wc, fr, fq); S.done(cur);
        if (!has_next) break;
#pragma unroll
        for (int a = 0; a < 2; ++a)
#pragma unroll
            for (int b = 0; b < 2; ++b)
#pragma unroll
                for (int m = 0; m < 4; ++m)
#pragma unroll
                    for (int n = 0; n < 2; ++n) acc[a][b][m][n] = (f32x4){0.f, 0.f, 0.f, 0.f};
        cur = nxt; cA = nA; cB = nB; ++ui;
        if (wr == 1) PG8_BAR;
    }
    PG8_WAIT_V(0);
    PG8_BAR;
#undef PG8_SA
#undef PG8_SB
#undef PG8_STAGE
#undef PG8_LDA
#undef PG8_LDB
#undef PG8_MMA
#undef PG8_WAIT_V
#undef PG8_WAIT_L
#undef PG8_BAR
#undef PG8_SCHED
}

typedef f32x4 Acc[2][2][4][2];

struct Epi1 {
    static constexpr bool PERM = true;
    bf16 *Qb, *Kb, *Vb, *QMb, *G, *MKb, *MVb; float* U; float* out;
    __device__ __forceinline__ void operator()(const Acc& acc, const Unit& u, int wr, int wc, int fr, int fq) const {
        asm volatile("" : "+v"(fr), "+v"(fq));
        const int pn = u.pn, pm = u.pm;
        bf16* bd = nullptr; int bld = 0; float* fd = nullptr; int fld = 0; float sc = 1.f; bool sig = false;
        if (pm >= 68) { const size_t r0 = (size_t)(pm - 68) * 256; bld = 256; fld = 256;
            if (pn == 20) { bd = MKb + r0 * 256; fd = out + O_MK + r0 * 256; } else { bd = MVb + r0 * 256; fd = out + O_MV + r0 * 256; } }
        else {
            const bool smp = pm >= 64; const size_t r0 = (size_t)pm * 256, f0 = smp ? (size_t)(pm - 64) * 256 : r0;
            if (pn < 2) { bd = Qb + r0 * 512 + pn * 256; bld = 512; sc = QSCALE; }
            else if (pn < 4) { bd = Kb + r0 * 512 + (pn - 2) * 256; bld = 512; fd = out + (smp ? O_KS : O_KP) + f0 * 512 + (pn - 2) * 256; fld = 512; }
            else if (pn < 6) { bd = Vb + r0 * 512 + (pn - 4) * 256; bld = 512; fd = out + (smp ? O_VS : O_VP) + f0 * 512 + (pn - 4) * 256; fld = 512; }
            else if (pn == 6) { fd = U + r0 * 256; fld = 256; }
            else if (pn == 7) { bd = QMb + r0 * 256; bld = 256; sc = QSCALE; }
            else { bd = G + r0 * 3072 + (pn - 8) * 256; bld = 3072; sig = true; }
        }
        const int cl = wc * 32 + 8 * fq;
#pragma unroll
        for (int ai = 0; ai < 2; ++ai)
#pragma unroll
            for (int m = 0; m < 4; ++m) { const size_t rr = (size_t)(128 * ai + 64 * wr + 16 * m + fr);
#pragma unroll
                for (int bj = 0; bj < 2; ++bj) { f32x4 v0 = acc[ai][bj][m][0], v1 = acc[ai][bj][m][1];
                    if (fd) { float* p = fd + rr * fld + 128 * bj + cl; *(f32x4*)p = v0; *(f32x4*)(p + 4) = v1; }
                    if (bd) {
                        if (sig) {
#pragma unroll
                            for (int j = 0; j < 4; ++j) { v0[j] = frcp(1.f + fexp2(-LOG2E * v0[j])); v1[j] = frcp(1.f + fexp2(-LOG2E * v1[j])); } }
                        v0 = v0 * sc; v1 = v1 * sc;
                        u32x4 w; w.x = pk2(v0[0], v0[1]); w.y = pk2(v0[2], v0[3]); w.z = pk2(v1[0], v1[1]); w.w = pk2(v1[2], v1[3]);
                        *(u32x4*)(bd + rr * bld + 128 * bj + cl) = w; } } }
    }
};

template <int MODE> struct Epi3 {
    static constexpr bool PERM = true;
    const bf16* G; float* TMP; bf16* MG;
    __device__ __forceinline__ void operator()(const Acc& acc, const Unit& u, int wr, int wc, int fr, int fq) const {
        asm volatile("" : "+v"(fr), "+v"(fq));
        const size_t row0 = (size_t)u.pm * 256; const int col0 = u.pn * 256 + wc * 32 + 8 * fq;
#pragma unroll
        for (int ai = 0; ai < 2; ++ai)
#pragma unroll
            for (int m = 0; m < 4; ++m) { const size_t r = row0 + (size_t)(128 * ai + 64 * wr + 16 * m + fr);
#pragma unroll
                for (int bj = 0; bj < 2; ++bj) { const int c = col0 + 128 * bj;
                    const u32x4 gw = *(const u32x4*)(G + r * 3072 + c);
                    f32x4 a0 = acc[ai][bj][m][0], a1 = acc[ai][bj][m][1];
                    a0[0] *= bflo(gw.x); a0[1] *= bfhi(gw.x); a0[2] *= bflo(gw.y); a0[3] *= bfhi(gw.y);
                    a1[0] *= bflo(gw.z); a1[1] *= bfhi(gw.z); a1[2] *= bflo(gw.w); a1[3] *= bfhi(gw.w);
                    float* tp = TMP + r * 1024 + c;
                    if (MODE >= 1) { a0 = a0 + *(const f32x4*)tp; a1 = a1 + *(const f32x4*)(tp + 4); }
                    if (MODE <= 1) { *(f32x4*)tp = a0; *(f32x4*)(tp + 4) = a1; }
                    else { u32x4 w; w.x = pk2(a0[0], a0[1]); w.y = pk2(a0[2], a0[3]); w.z = pk2(a1[0], a1[1]); w.w = pk2(a1[2], a1[3]); *(u32x4*)(MG + r * 1024 + c) = w; } }
                asm volatile("" ::: "memory"); }
    }
};

struct Epi4 {
    static constexpr bool PERM = true;
    const float *xp, *xs, *g2; float* X1; bf16* A2; float* SS;
    __device__ __forceinline__ void operator()(const Acc& acc, const Unit& u, int wr, int wc, int fr, int fq) const {
        asm volatile("" : "+v"(fr), "+v"(fq));
        const int pm = u.pm, pn = u.pn; const size_t row0 = (size_t)pm * 256;
        const float* xsrc = pm >= 64 ? xs + (size_t)(pm - 64) * 256 * 1024 : xp + row0 * 1024;
        const int col0 = pn * 256 + wc * 32 + 8 * fq;
        f32x4 gg[2][2];
#pragma unroll
        for (int bj = 0; bj < 2; ++bj)
#pragma unroll
            for (int n = 0; n < 2; ++n) gg[bj][n] = *(const f32x4*)(g2 + col0 + 128 * bj + 4 * n);
#pragma unroll
        for (int ai = 0; ai < 2; ++ai)
#pragma unroll
            for (int m = 0; m < 4; ++m) { const size_t rr = (size_t)(128 * ai + 64 * wr + 16 * m + fr); float s = 0.f;
#pragma unroll
                for (int bj = 0; bj < 2; ++bj) { const int c = col0 + 128 * bj;
                    const float* xr = xsrc + rr * 1024 + c;
                    const f32x4 v0 = *(const f32x4*)xr + acc[ai][bj][m][0], v1 = *(const f32x4*)(xr + 4) + acc[ai][bj][m][1];
                    float* xo = X1 + (row0 + rr) * 1024 + c; *(f32x4*)xo = v0; *(f32x4*)(xo + 4) = v1;
                    s += (v0[0] * v0[0] + v0[1] * v0[1]) + (v0[2] * v0[2] + v0[3] * v0[3]) + (v1[0] * v1[0] + v1[1] * v1[1]) + (v1[2] * v1[2] + v1[3] * v1[3]);
                    const f32x4 h0 = v0 * gg[bj][0], h1 = v1 * gg[bj][1];
                    u32x4 w; w.x = pk2(h0[0], h0[1]); w.y = pk2(h0[2], h0[3]); w.z = pk2(h1[0], h1[1]); w.w = pk2(h1[2], h1[3]);
                    *(u32x4*)(A2 + (row0 + rr) * 1024 + c) = w; }
                s = sum_g4(s);
                if (fq == 0) SS[(row0 + rr) * 16 + pn * 4 + wc] = s;
                asm volatile("" ::: "memory"); }
    }
};

struct Epi5 {
    static constexpr bool PERM = true;
    const float* SS; bf16 *GG, *UU; float* out;
    __device__ __forceinline__ void operator()(const Acc& acc, const Unit& u, int wr, int wc, int fr, int fq) const {
        asm volatile("" : "+v"(fr), "+v"(fq));
        const size_t row0 = (size_t)u.pm * 256; const int ch0 = u.pn * 128 + wc * 32 + 8 * fq;
#pragma unroll
        for (int ai = 0; ai < 2; ++ai)
#pragma unroll
            for (int m = 0; m < 4; ++m) { const size_t r = row0 + (size_t)(128 * ai + 64 * wr + 16 * m + fr);
                const f32x4* sp = (const f32x4*)(SS + r * 16); const f32x4 s0 = sp[0], s1 = sp[1], s2 = sp[2], s3 = sp[3];
                const float ss = ((s0[0] + s0[1]) + (s0[2] + s0[3])) + ((s1[0] + s1[1]) + (s1[2] + s1[3])) + ((s2[0] + s2[1]) + (s2[2] + s2[3])) + ((s3[0] + s3[1]) + (s3[2] + s3[3]));
                const float rstd = frsq(ss * (1.f / 1024.f) + EPS);
                const f32x4 g0 = acc[ai][0][m][0] * rstd, g1 = acc[ai][0][m][1] * rstd, u0 = acc[ai][1][m][0] * rstd, u1 = acc[ai][1][m][1] * rstd;
                u32x4 w; w.x = pk2(g0[0], g0[1]); w.y = pk2(g0[2], g0[3]); w.z = pk2(g1[0], g1[1]); w.w = pk2(g1[2], g1[3]);
                *(u32x4*)(GG + r * DFF + ch0) = w;
                w.x = pk2(u0[0], u0[1]); w.y = pk2(u0[2], u0[3]); w.z = pk2(u1[0], u1[1]); w.w = pk2(u1[2], u1[3]);
                *(u32x4*)(UU + r * DFF + ch0) = w;
                const int ri = (int)r;
                if (ri < MP) { const int t = ri & (SEQ - 1); if (t >= SEQ - 2) { float* p = out + O_CONVP + ((size_t)(ri >> 11) * 2 + (t - (SEQ - 2))) * DFF + ch0; *(f32x4*)p = g0; *(f32x4*)(p + 4) = g1; } }
                else { const int rs = ri - MP, q = rs & 7; if (q >= 6) { float* p = out + O_CONVS + ((size_t)(rs >> 3) * 2 + (q - 6)) * DFF + ch0; *(f32x4*)p = g0; *(f32x4*)(p + 4) = g1; } }
                asm volatile("" ::: "memory"); }
    }
};

struct Epi6 {
    static constexpr bool PERM = true;
    const float* X1; float* X2;
    __device__ __forceinline__ void operator()(const Acc& acc, const Unit& u, int wr, int wc, int fr, int fq) const {
        asm volatile("" : "+v"(fr), "+v"(fq));
        const size_t row0 = (size_t)u.pm * 256; const int col0 = u.pn * 256 + wc * 32 + 8 * fq;
#pragma unroll
        for (int ai = 0; ai < 2; ++ai)
#pragma unroll
            for (int m = 0; m < 4; ++m) { const size_t r = row0 + (size_t)(128 * ai + 64 * wr + 16 * m + fr);
#pragma unroll
                for (int bj = 0; bj < 2; ++bj) { const size_t o = r * 1024 + col0 + 128 * bj;
                    const f32x4 v0 = *(const f32x4*)(X1 + o) + acc[ai][bj][m][0], v1 = *(const f32x4*)(X1 + o + 4) + acc[ai][bj][m][1];
                    *(f32x4*)(X2 + o) = v0; *(f32x4*)(X2 + o + 4) = v1; }
                asm volatile("" ::: "memory"); }
    }
};
}

#define XB_TMO      128
#define XB_XCNT(j)  (256  + 64 * (j))
#define XB_XSUB(j)  (1280 + 64 * (j))
#define XB_XGEN(j)  (2304 + 64 * (j))
#define XB_TOP      3328
#define XB_TOPGEN   3392
#define XCD_BAR_WORDS 3456
#define XB_SPIN_CAP (1u << 18)
__device__ __forceinline__ unsigned xb_ld(unsigned* p)              { return __hip_atomic_load(p, __ATOMIC_RELAXED, __HIP_MEMORY_SCOPE_AGENT); }
__device__ __forceinline__ unsigned xb_add(unsigned* p, unsigned v) { return __hip_atomic_fetch_add(p, v, __ATOMIC_RELAXED, __HIP_MEMORY_SCOPE_AGENT); }
__device__ __forceinline__ unsigned xb_xcc_id() { return (unsigned)__builtin_amdgcn_s_getreg((3 << 11) | 20) & 0xFu; }
#define XB_SPIN(cond, bar) do { unsigned _sp = 0; while (cond) { __builtin_amdgcn_s_sleep(1); \
    if ((++_sp & 255u) == 0u) { if (xb_ld(&(bar)[XB_TMO])) break; if (_sp > XB_SPIN_CAP) { atomicAdd(&(bar)[XB_TMO], 1u); break; } } } } while (0)
struct XcdBarrier { unsigned* bar; unsigned x; volatile LAS unsigned* st; };
__device__ __forceinline__ XcdBarrier xcd_barrier_post(unsigned* bar, volatile LAS unsigned* st) {
    XcdBarrier b; b.bar = bar; b.x = xb_xcc_id(); b.st = st;
    if (threadIdx.x == 0) (void)xb_add(&bar[XB_XCNT(b.x)], 1u);
    return b;
}
__device__ __forceinline__ void xcd_barrier_complete(unsigned* bar, unsigned x, unsigned& nloc, unsigned& nx) {
    const unsigned G = gridDim.x * gridDim.y * gridDim.z;
    unsigned sum, cnt, mine, sp = 0u;
    for (;;) {
        sum = 0u; cnt = 0u; mine = 0u;
#pragma unroll
        for (unsigned j = 0; j < 16; ++j) { const unsigned c = xb_ld(&bar[XB_XCNT(j)]); sum += c; cnt += (c > 0u) ? 1u : 0u; mine = (j == x) ? c : mine; }
        if (sum == G) break;
        __builtin_amdgcn_s_sleep(1);
        if ((++sp & 255u) == 0u) { if (xb_ld(&bar[XB_TMO])) break; if (sp > XB_SPIN_CAP) { atomicAdd(&bar[XB_TMO], 1u); break; } }
    }
    nloc = mine > 0u ? mine : 1u; nx = cnt > 0u ? cnt : 1u;
}
__device__ __forceinline__ void xcd_barrier(const XcdBarrier& b) {
    asm volatile("s_waitcnt vmcnt(0)" ::: "memory");
    __syncthreads();
    if (threadIdx.x == 0) {
        unsigned* bar = b.bar;
        __builtin_amdgcn_s_waitcnt(0);
        unsigned nloc = b.st[0], nx = b.st[1];
        if (nloc == 0u) { xcd_barrier_complete(bar, b.x, nloc, nx); b.st[0] = nloc; b.st[1] = nx; }
        const unsigned old = xb_add(&bar[XB_XSUB(b.x)], 1u);
        const unsigned gen = old / nloc;
        if (old + 1u == (gen + 1u) * nloc) {
            __builtin_amdgcn_fence(__ATOMIC_RELEASE, "agent");
            asm volatile("s_waitcnt vmcnt(0)" ::: "memory");
            const unsigned og = xb_add(&bar[XB_TOP], 1u);
            const unsigned tg = og / nx;
            if (og + 1u == (tg + 1u) * nx) xb_add(&bar[XB_TOPGEN], 1u);
            else XB_SPIN(xb_ld(&bar[XB_TOPGEN]) == tg, bar);
            __builtin_amdgcn_fence(__ATOMIC_ACQUIRE, "agent");
            xb_add(&bar[XB_XGEN(b.x)], 1u);
            asm volatile("s_waitcnt vmcnt(0)" ::: "memory");
        } else {
            XB_SPIN(xb_ld(&bar[XB_XGEN(b.x)]) == gen, bar);
            __builtin_amdgcn_fence(__ATOMIC_ACQUIRE, "agent");
            asm volatile("s_waitcnt vmcnt(0)" ::: "memory");
        }
    }
    __syncthreads();
}

constexpr int NWAVES = 8, NTHR = 512;
constexpr int RING_BYTES = 131072, LDSCTL_OFF = RING_BYTES, MISC_OFF = LDSCTL_OFF + 320, LDS_BYTES = 147456;
struct Args { const void* in[33]; float* out; unsigned char* ws; };

__device__ __forceinline__ void p0_transpose_item(const float* W, int N, bf16* WT, int ldt, int koff, int row_off, int mode, LAS float* scr, int item, int lane) {
    const int nblk = N / 32, kb = item / nblk, nb = item % nblk, k0 = 64 * kb, n0 = 32 * nb;
#pragma unroll 8
    for (int i = 0; i < 32; ++i) { const int kk = 2 * i + (lane >> 5); scr[kk * 33 + (lane & 31)] = W[(size_t)(k0 + kk) * N + n0 + (lane & 31)]; }
    asm volatile("s_waitcnt lgkmcnt(0)" ::: "memory");
    const int c = lane & 7;
    const int rbase = mode == 0 ? row_off + n0 : (256 * (n0 >> 7) + (n0 & 127) + (mode == 2 ? 128 : 0));
#pragma unroll
    for (int j = 0; j < 4; ++j) { const int n = (lane >> 3) + 8 * j; const LAS float* s = scr + (8 * c) * 33 + n;
        u32x4 o; o.x = pk2(s[0 * 33], s[1 * 33]); o.y = pk2(s[2 * 33], s[3 * 33]); o.z = pk2(s[4 * 33], s[5 * 33]); o.w = pk2(s[6 * 33], s[7 * 33]);
        *(u32x4*)(WT + (size_t)(rbase + n) * ldt + koff + k0 + 8 * c) = o; }
    asm volatile("s_waitcnt lgkmcnt(0)" ::: "memory");
}
__device__ __forceinline__ void rms_row_to_bf16(const float* xrow, const float* gain, bf16* orow, int lane) {
    const f32x4* xr = (const f32x4*)xrow + lane; const f32x4* gr = (const f32x4*)gain + lane;
    f32x4 v[4]; float s = 0.f;
#pragma unroll
    for (int j = 0; j < 4; ++j) { v[j] = xr[64 * j]; s += (v[j][0] * v[j][0] + v[j][1] * v[j][1]) + (v[j][2] * v[j][2] + v[j][3] * v[j][3]); }
    const float rstd = frsq(wave_sum(s) * (1.f / 1024.f) + EPS);
    u32x2* o8 = (u32x2*)orow + lane;
#pragma unroll
    for (int j = 0; j < 4; ++j) { const f32x4 gv = gr[64 * j]; u32x2 w; w.x = pk2(v[j][0] * rstd * gv[0], v[j][1] * rstd * gv[1]); w.y = pk2(v[j][2] * rstd * gv[2], v[j][3] * rstd * gv[3]); o8[64 * j] = w; }
}

template <int NMAP, int VD, bool CAUSAL>
__device__ __forceinline__ void flash_unit(LAS unsigned char* kv, const LAS float* T2h, const bf16* Qp, int qld, const bf16* Kp, int kld, const bf16* Vp, int vld,
                                           int NT, int qpos0, f32x4 (&O)[NMAP][VD / 16], float (&lsum)[NMAP], int tid, int wave, int lane) {
    constexpr int KROW = NMAP * 128, KPITCH = KROW + 32, VROW = VD * 2, VPITCH = VROW + 32, KBYTES = 64 * KPITCH, VBYTES = 64 * VPITCH, STG = KBYTES + VBYTES;
    constexpr int KCPR = KROW / 16, VCPR = VROW / 16, NKC = 64 * KCPR / NTHR, NVC = 64 * VCPR / NTHR, NDG = VD / 16;
    const int l16 = lane & 15, g = lane >> 4;
    bf16x8 qf[NMAP][2];
#pragma unroll
    for (int c = 0; c < NMAP; ++c)
#pragma unroll
        for (int ks = 0; ks < 2; ++ks) qf[c][ks] = *(const bf16x8*)(Qp + (size_t)(16 * wave + l16) * qld + c * 64 + ks * 32 + g * 8);
    float mrow[NMAP];
#pragma unroll
    for (int c = 0; c < NMAP; ++c) { mrow[c] = NEGB; lsum[c] = 0.f;
#pragma unroll
        for (int dg = 0; dg < NDG; ++dg) O[c][dg] = (f32x4){0.f, 0.f, 0.f, 0.f}; }
    u32x4 kr[NKC], vr[NVC];
    int krow[NKC], kch[NKC], vrow[NVC], vch[NVC];
#pragma unroll
    for (int i = 0; i < NKC; ++i) { const int idx = tid + i * NTHR; krow[i] = idx / KCPR; kch[i] = idx % KCPR; }
#pragma unroll
    for (int i = 0; i < NVC; ++i) { const int idx = tid + i * NTHR; vrow[i] = idx / VCPR; vch[i] = idx % VCPR; }
#define FL_GLOAD(t) do { _Pragma("unroll") for (int i = 0; i < NKC; ++i) kr[i] = *(const u32x4*)(Kp + (size_t)(64 * (t) + krow[i]) * kld + kch[i] * 8); \
                         _Pragma("unroll") for (int i = 0; i < NVC; ++i) vr[i] = *(const u32x4*)(Vp + (size_t)(64 * (t) + vrow[i]) * vld + vch[i] * 8); } while (0)
#define FL_LSTORE(buf) do { _Pragma("unroll") for (int i = 0; i < NKC; ++i) *(LAS u32x4*)(kv + (buf) * STG + krow[i] * KPITCH + kch[i] * 16) = kr[i]; \
                            _Pragma("unroll") for (int i = 0; i < NVC; ++i) *(LAS u32x4*)(kv + (buf) * STG + KBYTES + vrow[i] * VPITCH + vch[i] * 16) = vr[i]; } while (0)
    FL_GLOAD(0); FL_LSTORE(0);
    __syncthreads();
    const int qw0 = qpos0 + 16 * wave;
    for (int t = 0; t < NT; ++t) {
        const int buf = t & 1;
        if (t + 1 < NT) FL_GLOAD(t + 1);
        if (!CAUSAL || 64 * t <= qw0 + 15) {
            const LAS unsigned char* Kt = kv + buf * STG; const LAS unsigned char* Vt = Kt + KBYTES;
            f32x4 S[NMAP][4];
#pragma unroll
            for (int c = 0; c < NMAP; ++c)
#pragma unroll
                for (int kg = 0; kg < 4; ++kg) { f32x4 a = (f32x4){0.f, 0.f, 0.f, 0.f};
#pragma unroll
                    for (int ks = 0; ks < 2; ++ks) { const bf16x8 kf = *(const LAS bf16x8*)(Kt + (16 * kg + l16) * KPITCH + c * 128 + ks * 64 + g * 16);
                        a = __builtin_amdgcn_mfma_f32_16x16x32_bf16(kf, qf[c][ks], a, 0, 0, 0); }
                    S[c][kg] = a; }
            if (CAUSAL) {
                if (qw0 - (64 * t + 63) >= 128) { const float bfar = T2h[255];
#pragma unroll
                    for (int c = 0; c < NMAP; ++c)
#pragma unroll
                        for (int kg = 0; kg < 4; ++kg) S[c][kg] = S[c][kg] + bfar;
                } else {
#pragma unroll
                    for (int kg = 0; kg < 4; ++kg)
#pragma unroll
                        for (int i = 0; i < 4; ++i) { const int rel = (qw0 + l16) - (64 * t + 16 * kg + 4 * g + i); const float bb = T2h[rel < 0 ? 0 : (rel > 255 ? 255 : rel)];
#pragma unroll
                            for (int c = 0; c < NMAP; ++c) S[c][kg][i] = rel < 0 ? NEGB : S[c][kg][i] + bb; }
                }
            }
            bf16x8 pf[NMAP][2];
#pragma unroll
            for (int c = 0; c < NMAP; ++c) {
                float mx = S[c][0][0];
#pragma unroll
                for (int kg = 0; kg < 4; ++kg)
#pragma unroll
                    for (int i = 0; i < 4; ++i) mx = fmaxf(mx, S[c][kg][i]);
                mx = max_g4(mx);
                const float mn = fmaxf(mrow[c], mx), alpha = fexp2(mrow[c] - mn); mrow[c] = mn;
                float ps = 0.f;
#pragma unroll
                for (int kg = 0; kg < 4; ++kg)
#pragma unroll
                    for (int i = 0; i < 4; ++i) { const float p = fexp2(S[c][kg][i] - mn); S[c][kg][i] = p; ps += p; }
                lsum[c] = lsum[c] * alpha + ps;
#pragma unroll
                for (int dg = 0; dg < NDG; ++dg) O[c][dg] = O[c][dg] * alpha;
#pragma unroll
                for (int s = 0; s < 2; ++s) { u32x4 w; w.x = pk2(S[c][2 * s][0], S[c][2 * s][1]); w.y = pk2(S[c][2 * s][2], S[c][2 * s][3]);
                    w.z = pk2(S[c][2 * s + 1][0], S[c][2 * s + 1][1]); w.w = pk2(S[c][2 * s + 1][2], S[c][2 * s + 1][3]); pf[c][s] = __builtin_bit_cast(bf16x8, w); }
            }
#pragma unroll
            for (int dg = 0; dg < NDG; ++dg)
#pragma unroll
                for (int s = 0; s < 2; ++s) {
                    const LAS unsigned char* vp = Vt + (32 * s + 4 * g + (l16 >> 2)) * VPITCH + dg * 32 + (l16 & 3) * 8;
                    const s16x4 lo = __builtin_bit_cast(s16x4, __builtin_amdgcn_ds_read_tr16_b64_v4i16((LAS s16x4*)vp));
                    const s16x4 hi = __builtin_bit_cast(s16x4, __builtin_amdgcn_ds_read_tr16_b64_v4i16((LAS s16x4*)(vp + 16 * VPITCH)));
                    const bf16x8 vf = (bf16x8){lo[0], lo[1], lo[2], lo[3], hi[0], hi[1], hi[2], hi[3]};
#pragma unroll
                    for (int c = 0; c < NMAP; ++c) O[c][dg] = __builtin_amdgcn_mfma_f32_16x16x32_bf16(vf, pf[c][s], O[c][dg], 0, 0, 0);
                }
        }
        if (t + 1 < NT) FL_LSTORE(buf ^ 1);
        __syncthreads();
    }
#pragma unroll
    for (int c = 0; c < NMAP; ++c) { lsum[c] = sum_g4(lsum[c]); }
#undef FL_GLOAD
#undef FL_LSTORE
}

template <bool DIFF>
__device__ __forceinline__ void decode_item(LAS unsigned char* sm, const LAS float* T2h, int b, int h, const float* Kc, const float* Vc, const int* ptab,
                                            const bf16* Qrows  , int qld, const bf16* Knew, const bf16* Vnew  ,
                                            float lam, const float* subg, bf16* outp  , int tid, int wave, int lane) {
    constexpr int NG = DIFF ? 16 : 2, NKS = DIFF ? 4 : 2, NDG = DIFF ? 8 : 4, NS = NG / 2, VD = NDG * 16;
    asm volatile("" : "+v"(lane));
    const int l16 = lane & 15, g = lane >> 4, qn = l16 & 7, cn = l16 >> 3;
    bf16x8 qf[NKS];
#pragma unroll
    for (int ks = 0; ks < NKS; ++ks) {
        const bool on = DIFF ? (cn == (ks >> 1)) : (cn == 0);
        const bf16x8 z = (bf16x8){0, 0, 0, 0, 0, 0, 0, 0};
        const bf16x8 v = *(const bf16x8*)(Qrows + (size_t)qn * qld + 32 * ks + 8 * g);
        qf[ks] = on ? v : z;
    }
    int phys[2] = {0, 0};
    if (DIFF) { phys[0] = ptab[b * NPAGES + 2 * wave]; phys[1] = ptab[b * NPAGES + 2 * wave + 1]; }
    f32x4 S[NG + 1];
    f32x4 kb[2][2 * NKS];
#define DEC_KPTR(gi) (DIFF ? Kc + ((size_t)phys[(gi) >> 3] * 128 + 16 * ((gi) & 7) + l16) * 512 + h * 128 + 8 * g \
                           : Kc + ((size_t)(b * 256 + 32 * wave + 16 * (gi) + l16) * 4 + h) * 64 + 8 * g)
#define DEC_KLOAD(gi, dst) do { const float* kp_ = DEC_KPTR(gi); _Pragma("unroll") for (int ks = 0; ks < NKS; ++ks) { dst[2 * ks] = *(const f32x4*)(kp_ + 32 * ks); dst[2 * ks + 1] = *(const f32x4*)(kp_ + 32 * ks + 4); } } while (0)
    DEC_KLOAD(0, kb[0]);
#pragma unroll
    for (int gi = 0; gi < NG; ++gi) {
        if (gi + 1 < NG) DEC_KLOAD(gi + 1, kb[(gi + 1) & 1]);
        asm volatile("" ::: "memory");
        f32x4 a = (f32x4){0.f, 0.f, 0.f, 0.f};
#pragma unroll
        for (int ks = 0; ks < NKS; ++ks) { const f32x4 x0 = kb[gi & 1][2 * ks], x1 = kb[gi & 1][2 * ks + 1];
            u32x4 w; w.x = pk2(x0[0], x0[1]); w.y = pk2(x0[2], x0[3]); w.z = pk2(x1[0], x1[1]); w.w = pk2(x1[2], x1[3]);
            a = __builtin_amdgcn_mfma_f32_16x16x32_bf16(__builtin_bit_cast(bf16x8, w), qf[ks], a, 0, 0, 0); }
        S[gi] = a;
    }
#undef DEC_KLOAD
#undef DEC_KPTR
    S[NG] = (f32x4){NEGB, NEGB, NEGB, NEGB};
    if (DIFF) {
#pragma unroll
        for (int gi = 0; gi < NG; ++gi) {
            if (wave < 7 || gi < 8) { const float bfar = T2h[255]; S[gi] = S[gi] + bfar; }
            else {
#pragma unroll
                for (int i = 0; i < 4; ++i) { int rel = 2048 + qn - (256 * wave + 16 * gi + 4 * g + i); rel = rel > 255 ? 255 : rel; S[gi][i] += T2h[rel]; } }
        }
        if (wave == 0) {
            const int jr = l16 < 8 ? l16 : 7;
            f32x4 a = (f32x4){0.f, 0.f, 0.f, 0.f};
#pragma unroll
            for (int ks = 0; ks < NKS; ++ks) { const bf16x8 kf = *(const bf16x8*)(Knew + (size_t)jr * 512 + 32 * ks + 8 * g);
                a = __builtin_amdgcn_mfma_f32_16x16x32_bf16(kf, qf[ks], a, 0, 0, 0); }
#pragma unroll
            for (int i = 0; i < 4; ++i) { const int j = 4 * g + i; const int rel = qn - j; a[i] = (j < 8 && rel >= 0) ? a[i] + T2h[rel < 0 ? 0 : rel] : NEGB; }
            S[NG] = a;
        }
    }
    float mx = S[0][0];
#pragma unroll
    for (int gi = 0; gi < NG + 1; ++gi) { if (gi == NG && !DIFF) continue;
#pragma unroll
        for (int i = 0; i < 4; ++i) mx = fmaxf(mx, S[gi][i]); }
    mx = max_g4(mx);
    float ps = 0.f;
#pragma unroll
    for (int gi = 0; gi < NG + 1; ++gi) { if (gi == NG && !DIFF) continue;
#pragma unroll
        for (int i = 0; i < 4; ++i) { const float p = fexp2(S[gi][i] - mx); S[gi][i] = p; ps += p; } }
    ps = sum_g4(ps);
    f32x4 O[NDG];
#pragma unroll
    for (int dg = 0; dg < NDG; ++dg) O[dg] = (f32x4){0.f, 0.f, 0.f, 0.f};
    constexpr int VRS = DIFF ? 512 : 256;
    constexpr int NVB = NS * (NDG / 4);
    float vb[2][32];
#define DEC_VPTR(s) (DIFF ? Vc + ((size_t)phys[(s) >> 2] * 128 + 32 * ((s) & 3) + 4 * g) * 512 + h * 128 + l16 \
                          : Vc + ((size_t)(b * 256 + 32 * wave + 4 * g) * 4 + h) * 64 + l16)
#define DEC_VLOAD(bt, dst) do { const float* vp_ = DEC_VPTR((bt) / (NDG / 4)) + 64 * ((bt) % (NDG / 4)); _Pragma("unroll") for (int d4 = 0; d4 < 4; ++d4) _Pragma("unroll") for (int j = 0; j < 4; ++j) { \
        dst[8 * d4 + j] = vp_[(size_t)j * VRS + 16 * d4]; dst[8 * d4 + 4 + j] = vp_[(size_t)(16 + j) * VRS + 16 * d4]; } } while (0)
    DEC_VLOAD(0, vb[0]);
#pragma unroll
    for (int bt = 0; bt < NVB; ++bt) {
        if (bt + 1 < NVB) DEC_VLOAD(bt + 1, vb[(bt + 1) & 1]);
        asm volatile("" ::: "memory");
        const int s = bt / (NDG / 4), dgh = bt % (NDG / 4);
        u32x4 pw; pw.x = pk2(S[2 * s][0], S[2 * s][1]); pw.y = pk2(S[2 * s][2], S[2 * s][3]); pw.z = pk2(S[2 * s + 1][0], S[2 * s + 1][1]); pw.w = pk2(S[2 * s + 1][2], S[2 * s + 1][3]);
        const bf16x8 pf = __builtin_bit_cast(bf16x8, pw);
#pragma unroll
        for (int d4 = 0; d4 < 4; ++d4) { const float* x = &vb[bt & 1][8 * d4];
            u32x4 w; w.x = pk2(x[0], x[1]); w.y = pk2(x[2], x[3]); w.z = pk2(x[4], x[5]); w.w = pk2(x[6], x[7]);
            O[4 * dgh + d4] = __builtin_amdgcn_mfma_f32_16x16x32_bf16(__builtin_bit_cast(bf16x8, w), pf, O[4 * dgh + d4], 0, 0, 0); }
    }
#undef DEC_VLOAD
#undef DEC_VPTR
    if (DIFF && wave == 0) {
        u32x4 pw; pw.x = pk2(S[NG][0], S[NG][1]); pw.y = pk2(S[NG][2], S[NG][3]); pw.z = 0u; pw.w = 0u;
        const bf16x8 pf = __builtin_bit_cast(bf16x8, pw);
#pragma unroll
        for (int dg = 0; dg < NDG; ++dg) {
            unsigned short x[4];
#pragma unroll
            for (int j = 0; j < 4; ++j) { int kj = 4 * g + j; kj = kj < 8 ? kj : 7; x[j] = Vnew[(size_t)kj * 512 + 16 * dg + l16]; }
            u32x4 w; w.x = (unsigned)x[0] | ((unsigned)x[1] << 16); w.y = (unsigned)x[2] | ((unsigned)x[3] << 16); w.z = 0u; w.w = 0u;
            O[dg] = __builtin_amdgcn_mfma_f32_16x16x32_bf16(__builtin_bit_cast(bf16x8, w), pf, O[dg], 0, 0, 0);
        }
    }
    LAS float* OC = (LAS float*)sm; LAS float* ML = (LAS float*)(sm + 8 * 16 * VD * 4);
#pragma unroll
    for (int dg = 0; dg < NDG; ++dg) *(LAS f32x4*)(OC + (wave * 16 + l16) * VD + 16 * dg + 4 * g) = O[dg];
    if (g == 0) { ML[(wave * 16 + l16) * 2] = mx; ML[(wave * 16 + l16) * 2 + 1] = ps; }
    __syncthreads();
    {
        constexpr int DPL = VD / 64;
        const int q = wave;
        float o[DPL];
#pragma unroll
        for (int e = 0; e < DPL; ++e) o[e] = 0.f;
#pragma unroll
        for (int c = 0; c < (DIFF ? 2 : 1); ++c) { const int n = c * 8 + q;
            float M = NEGB;
#pragma unroll
            for (int w = 0; w < 8; ++w) M = fmaxf(M, ML[(w * 16 + n) * 2]);
            float L = 0.f, acc[DPL];
#pragma unroll
            for (int e = 0; e < DPL; ++e) acc[e] = 0.f;
#pragma unroll
            for (int w = 0; w < 8; ++w) { const float f = fexp2(ML[(w * 16 + n) * 2] - M); L += ML[(w * 16 + n) * 2 + 1] * f;
#pragma unroll
                for (int e = 0; e < DPL; ++e) acc[e] += OC[(w * 16 + n) * VD + DPL * lane + e] * f; }
            const float il = 1.f / L;
#pragma unroll
            for (int e = 0; e < DPL; ++e) o[e] += (c == 0 ? 1.f : -lam) * acc[e] * il;
        }
        if (DIFF) {
            const float ss = wave_sum(o[0] * o[0] + o[DPL - 1] * o[DPL - 1]);
            const float r = frsq(ss * (1.f / 128.f) + EPS) * (1.f - LAM_INIT);
            const unsigned w = pk2(o[0] * r * subg[DPL * lane], o[DPL - 1] * r * subg[DPL * lane + DPL - 1]);
            *(unsigned*)(outp + (size_t)q * 1024 + 2 * lane) = w;
        } else {
            const unsigned short v = (unsigned short)(pk2(o[0], 0.f) & 0xffffu);
            outp[(size_t)q * 1024 + lane] = v;
        }
    }
    __syncthreads();
}

#define x_prompt ((const float*)KA(0))
#define x_sample ((const float*)KA(1))
#define mem_prompt ((const float*)KA(2))
#define cache_k ((const float*)KA(3))
#define cache_v ((const float*)KA(4))
#define page_table ((const int*)KA(5))
#define state_pool ((const float*)KA(6))
#define state_conv ((const float*)KA(7))
#define cache_mem_k ((const float*)KA(8))
#define cache_mem_v ((const float*)KA(9))
#define norm1_g ((const float*)KA(10))
#define w_in ((const float*)KA(11))
#define lam_q1 ((const float*)KA(12))
#define lam_k1 ((const float*)KA(13))
#define lam_q2 ((const float*)KA(14))
#define lam_k2 ((const float*)KA(15))
#define subln_g ((const float*)KA(16))
#define w_pool_grp ((const float*)KA(17))
#define pool_scale ((const float*)KA(18))
#define w_br_attn ((const float*)KA(19))
#define w_br_pool ((const float*)KA(20))
#define w_br_mem ((const float*)KA(21))
#define mem_norm_g ((const float*)KA(22))
#define w_mem_kv ((const float*)KA(23))
#define w_out ((const float*)KA(24))
#define norm2_g ((const float*)KA(25))
#define w_ffn_gate ((const float*)KA(26))
#define w_ffn_up ((const float*)KA(27))
#define conv_w ((const float*)KA(28))
#define conv_b ((const float*)KA(29))
#define w_ffn_down ((const float*)KA(30))
#define rel_bias ((const float*)KA(31))
#define final_g ((const float*)KA(32))
#define W1t ((bf16*)(ws + WS_W1T))
#define Wbrt ((bf16*)(ws + WS_WBR))
#define Woutt ((bf16*)(ws + WS_WOUT))
#define Wgut ((bf16*)(ws + WS_WGU))
#define Wdt ((bf16*)(ws + WS_WD))
#define XN ((bf16*)(ws + WS_XN))
#define Qb ((bf16*)(ws + WS_QB))
#define Kb ((bf16*)(ws + WS_KB))
#define Vb ((bf16*)(ws + WS_VB))
#define QMb ((bf16*)(ws + WS_QMB))
#define U ((float*)(ws + WS_U))
#define Gt ((bf16*)(ws + WS_G))
#define MKb ((bf16*)(ws + WS_MKB))
#define MVb ((bf16*)(ws + WS_MVB))
#define BR ((bf16*)(ws + WS_BR))
#define TMP ((float*)(ws + WS_TMP))
#define MG ((bf16*)(ws + WS_MG))
#define X1 ((float*)(ws + WS_X1))
#define A2 ((bf16*)(ws + WS_A2))
#define SS ((float*)(ws + WS_SS))
#define GG ((bf16*)(ws + WS_GG))
#define UU ((bf16*)(ws + WS_UU))
#define ACT ((bf16*)(ws + WS_ACT))
#define X2 ((float*)(ws + WS_X2))
typedef const __attribute__((address_space(4))) unsigned long long* KAP;
#define KA(i) ((void*)ka_l[i])
#define ws ((unsigned char*)KA(34))
#define out ((float*)KA(33))
#define LANE_INIT() do { asm volatile("v_mbcnt_lo_u32_b32 %0, -1, 0\n\tv_mbcnt_hi_u32_b32 %0, -1, %0" : "=v"(lane)); wave = wave_s; tid = wave * 64 + lane; } while (0)
#define PHASE_ARGS() do { ka_l = ka; asm volatile("" : "+s"(ka_l)); LANE_INIT(); gw = vcu * NWAVES + wave; } while (0)
__global__ void __launch_bounds__(NTHR, 2) fwd_kernel(Args args) {
    extern __shared__ __attribute__((aligned(16))) unsigned char lds_raw[];
    LAS unsigned char* lds = (LAS unsigned char*)lds_raw;
    volatile LAS unsigned* MISC = (volatile LAS unsigned*)(lds + MISC_OFF);
    const int wave_s = __builtin_amdgcn_readfirstlane((int)threadIdx.x >> 6);
    int lane, tid, wave; LANE_INIT();
    const int G = gridDim.x; const int bx = blockIdx.x; const int vcu = (G % 8 == 0) ? (bx % 8) * (G / 8) + bx / 8 : bx;
    const KAP ka = (KAP)__builtin_amdgcn_kernarg_segment_ptr();
    KAP ka_l = ka; asm volatile("" : "+s"(ka_l));
    for (int u = tid; u < (LDS_BYTES - LDSCTL_OFF) / 4; u += NTHR) ((LAS unsigned*)(lds + LDSCTL_OFF))[u] = 0u;
    __syncthreads();
    XcdBarrier bar = xcd_barrier_post((unsigned*)(ws + WS_CTL) + CW_BAR, MISC + 8);
    int gw = vcu * NWAVES + wave; const int NGW = G * NWAVES;

    {
        LAS float* scr = (LAS float*)(lds + wave * 16384);
        constexpr int I1 = 16 * 160, I2 = 16 * 16, I3 = 8 * 32, I4 = 4 * 32, I5 = 4 * 32, I6 = 16 * 32, I7 = 16 * 88, I8 = 16 * 88, I9 = 44 * 32;
        constexpr int NITEMS = I1 + I2 + I3 + I4 + I5 + I6 + I7 + I8 + I9;
        for (int it = gw; it < NITEMS; it += NGW) {
            int r = it;
            if (r < I1) { p0_transpose_item(w_in, 5120, W1t, 1024, 0, 0, 0, scr, r, lane); continue; } r -= I1;
            if (r < I2) { p0_transpose_item(w_mem_kv, 512, W1t, 1024, 0, 5120, 0, scr, r, lane); continue; } r -= I2;
            if (r < I3) { p0_transpose_item(w_br_attn, 1024, Wbrt, 1024, 0, 0, 0, scr, r, lane); continue; } r -= I3;
            if (r < I4) { p0_transpose_item(w_br_pool, 1024, Wbrt, 1024, 512, 0, 0, scr, r, lane); continue; } r -= I4;
            if (r < I5) { p0_transpose_item(w_br_mem, 1024, Wbrt, 1024, 768, 0, 0, scr, r, lane); continue; } r -= I5;
            if (r < I6) { p0_transpose_item(w_out, 1024, Woutt, 1024, 0, 0, 0, scr, r, lane); continue; } r -= I6;
            if (r < I7) { p0_transpose_item(w_ffn_gate, DFF, Wgut, 1024, 0, 0, 1, scr, r, lane); continue; } r -= I7;
            if (r < I8) { p0_transpose_item(w_ffn_up, DFF, Wgut, 1024, 0, 0, 2, scr, r, lane); continue; } r -= I8;
            p0_transpose_item(w_ffn_down, 1024, Wdt, DFF, 0, 0, 0, scr, r, lane);
        }
        for (int m = gw; m < MA; m += NGW) {
            const float* src; const float* gain;
            if (m < MP) { src = x_prompt + (size_t)m * D; gain = norm1_g; }
            else if (m < MT) { src = x_sample + (size_t)(m - MP) * D; gain = norm1_g; }
            else { src = mem_prompt + (size_t)(m - MT) * D; gain = mem_norm_g; }
            rms_row_to_bf16(src, gain, XN + (size_t)m * D, lane);
        }
    }
    xcd_barrier(bar); PHASE_ARGS();

    {
        pg8::Gemm g{XN, W1t, 1024, 1024, 1024}; pg8::Order1 S; S.init(G, bx);
        pg8::Epi1 E{Qb, Kb, Vb, QMb, Gt, MKb, MVb, U, out};
        pg8::gemm_phase<pg8::Epi1, pg8::Order1>(lds, g, S, E, tid);
    }
    xcd_barrier(bar); PHASE_ARGS();

    {
        LAS float* T2 = (LAS float*)lds;
        LAS unsigned char* sm = lds + 4096;
        for (int idx = tid; idx < 1024; idx += NTHR) { const int hh = idx >> 8, n = idx & 255;
            int bk = n;
            if (n >= 16) { const float nf = (float)n; int lg = 16 + (int)(logf(nf / 16.f) / 2.0794415416798357f * 16.f); bk = lg < 31 ? lg : 31; }
            T2[idx] = rel_bias[bk * 4 + hh] * LOG2E; }
        const float e1 = wave_sum(lam_q1[lane] * lam_k1[lane]), e2 = wave_sum(lam_q2[lane] * lam_k2[lane]);
        const float lam = expf(e1) - expf(e2) + LAM_INIT;
        __syncthreads();
        const int l16 = lane & 15, g4 = lane >> 4;
        for (int p = vcu; p < 256; p += G) {
            const int bh = p >> 3, s = p & 7, b = bh >> 2, h = bh & 3;
            for (int half = 0; half < 2; ++half) {
                const int qb = half == 0 ? s : 15 - s; const int q0 = 128 * qb; const size_t rb = (size_t)b * SEQ;
                f32x4 O[2][8]; float ls[2];
                flash_unit<2, 128, true>(sm, T2 + h * 256, Qb + (rb + q0) * 512 + h * 128, 512, Kb + rb * 512 + h * 128, 512, Vb + rb * 512 + h * 128, 512,
                                         2 * qb + 2, q0, O, ls, tid, wave, lane);
                const float i0 = 1.f / ls[0], i1 = lam / ls[1];
                float ss = 0.f;
#pragma unroll
                for (int dg = 0; dg < 8; ++dg) { O[0][dg] = O[0][dg] * i0 - O[1][dg] * i1; ss += (O[0][dg][0] * O[0][dg][0] + O[0][dg][1] * O[0][dg][1]) + (O[0][dg][2] * O[0][dg][2] + O[0][dg][3] * O[0][dg][3]); }
                ss = sum_g4(ss);
                const float r = frsq(ss * (1.f / 128.f) + EPS) * (1.f - LAM_INIT);
                bf16* op = BR + (rb + q0 + 16 * wave + l16) * 1024 + h * 128 + 4 * g4;
#pragma unroll
                for (int dg = 0; dg < 8; ++dg) { const f32x4 sg = *(const f32x4*)(subln_g + 16 * dg + 4 * g4); const f32x4 o = O[0][dg] * r * sg;
                    u32x2 w; w.x = pk2(o[0], o[1]); w.y = pk2(o[2], o[3]); *(u32x2*)(op + 16 * dg) = w; }
            }
        }
        for (int it = vcu; it < DB * 4; it += G) {
            const int b = it >> 2, h = it & 3; const size_t r0 = (size_t)MP + (size_t)b * DS;
            decode_item<true>(sm, T2 + h * 256, b, h, cache_k, cache_v, page_table, Qb + r0 * 512 + h * 128, 512, Kb + r0 * 512 + h * 128, Vb + r0 * 512 + h * 128,
                              lam, subln_g, BR + r0 * 1024 + h * 128, tid, wave, lane);
        }
        for (int un = vcu; un < 512; un += G) {
            const int bh = un >> 4, qb = un & 15, b = bh >> 2, h = bh & 3; const size_t rb = (size_t)b * SEQ + 128 * qb;
            f32x4 O[1][4]; float ls[1];
            flash_unit<1, 64, false>(sm, T2, QMb + rb * 256 + h * 64, 256, MKb + (size_t)b * 256 * 256 + h * 64, 256, MVb + (size_t)b * 256 * 256 + h * 64, 256, 4, 0, O, ls, tid, wave, lane);
            const float i0 = 1.f / ls[0];
            bf16* op = BR + (rb + 16 * wave + l16) * 1024 + 768 + h * 64 + 4 * g4;
#pragma unroll
            for (int dg = 0; dg < 4; ++dg) { const f32x4 o = O[0][dg] * i0; u32x2 w; w.x = pk2(o[0], o[1]); w.y = pk2(o[2], o[3]); *(u32x2*)(op + 16 * dg) = w; }
        }
        for (int it = vcu; it < DB * 4; it += G) {
            const int b = it >> 2, h = it & 3; const size_t r0 = (size_t)MP + (size_t)b * DS;
            decode_item<false>(sm, T2, b, h, cache_mem_k, cache_mem_v, page_table, QMb + r0 * 256 + h * 64, 256, nullptr, nullptr, 0.f, subln_g, BR + r0 * 1024 + 768 + h * 64, tid, wave, lane);
        }
        {
            LAS float* E = (LAS float*)sm;
            LAS float* Dt = (LAS float*)(sm + 46 * 1024);
            for (int ti = vcu; ti < MT / 16; ti += G) {
                const bool smp = ti >= MP / 16;
                if (!smp) { const int r0 = 16 * ti, t0 = r0 & (SEQ - 1);
                    for (int idx = tid; idx < 31 * 64; idx += NTHR) { const int j = idx >> 6, c4 = idx & 63; const int t = t0 - 15 + j;
                        f32x4 v = (f32x4){0.f, 0.f, 0.f, 0.f}; if (t >= 0) v = *(const f32x4*)(U + (size_t)(r0 - 15 + j) * 256 + 4 * c4);
                        *(LAS f32x4*)(E + j * 256 + 4 * c4) = v; }
                } else { const int b0 = 2 * (ti - MP / 16);
                    for (int idx = tid; idx < 46 * 64; idx += NTHR) { const int jj = idx >> 6, c4 = idx & 63; const int sq = jj / 23, j = jj % 23; const int b = b0 + sq;
                        const f32x4 v = j < 15 ? *(const f32x4*)(state_pool + ((size_t)b * 15 + j) * 256 + 4 * c4) : *(const f32x4*)(U + ((size_t)MP + (size_t)b * 8 + (j - 15)) * 256 + 4 * c4);
                        *(LAS f32x4*)(E + jj * 256 + 4 * c4) = v; }
                }
                __syncthreads();
                {   const int ch = tid & 255, gi = ch >> 6, w = 2 << gi;
#pragma unroll
                    for (int k = 0; k < 8; ++k) { const int tk = (tid >> 8) + 2 * k;
                        int base, cnt;
                        if (!smp) { base = 15 + tk; const int pos = ((16 * ti) & (SEQ - 1)) + tk; cnt = pos + 1 < w ? pos + 1 : w; }
                        else { base = (tk >> 3) * 23 + 15 + (tk & 7); cnt = w; }
                        float sacc = 0.f;
                        for (int j = 0; j < w; ++j) sacc += E[(base - j) * 256 + ch];
                        Dt[tk * 256 + ch] = sacc / (float)cnt - E[base * 256 + ch]; }
                }
                __syncthreads();
                {   const int och = tid & 255, gi = och >> 6, o = och & 63, th = tid >> 8;
                    float acc[8];
#pragma unroll
                    for (int k = 0; k < 8; ++k) acc[k] = 0.f;
                    const float* wp = w_pool_grp + (size_t)gi * 4096 + o;
                    for (int c = 0; c < 64; c += 4) {
                        const float w0 = wp[(c + 0) * 64], w1 = wp[(c + 1) * 64], w2 = wp[(c + 2) * 64], w3 = wp[(c + 3) * 64];
#pragma unroll
                        for (int k = 0; k < 8; ++k) { const f32x4 dv = *(const LAS f32x4*)(Dt + (8 * th + k) * 256 + gi * 64 + c); acc[k] += dv[0] * w0 + dv[1] * w1 + dv[2] * w2 + dv[3] * w3; }
                    }
                    const float psc = pool_scale[och];
#pragma unroll
                    for (int k = 0; k < 8; ++k) BR[(size_t)(16 * ti + 8 * th + k) * 1024 + 512 + och] = (bf16)(pk2(acc[k] * psc, 0.f) & 0xffffu);
                }
                __syncthreads();
            }
            for (int idx = bx * NTHR + tid; idx < (NB + DB) * 15 * 64; idx += G * NTHR) {
                const int c4 = idx & 63, rj = idx >> 6;
                if (rj < NB * 15) { const int b = rj / 15, j = rj % 15; *(f32x4*)(out + O_POOLP + (size_t)rj * 256 + 4 * c4) = *(const f32x4*)(U + ((size_t)b * SEQ + SEQ - 15 + j) * 256 + 4 * c4); }
                else { const int r2 = rj - NB * 15, b = r2 / 15, j = r2 % 15;
                    const f32x4 v = j < 7 ? *(const f32x4*)(state_pool + ((size_t)b * 15 + 8 + j) * 256 + 4 * c4) : *(const f32x4*)(U + ((size_t)MP + (size_t)b * 8 + (j - 7)) * 256 + 4 * c4);
                    *(f32x4*)(out + O_POOLS + (size_t)r2 * 256 + 4 * c4) = v; }
            }
        }
    }
    xcd_barrier(bar); PHASE_ARGS();

    {
        pg8::StaticOrder S; S.init(MT, 1024, G, bx);
        { pg8::Gemm g{BR, Wbrt, 512, 1024, 1024}; pg8::Epi3<0> E{Gt, TMP, MG}; pg8::gemm_phase<pg8::Epi3<0>, pg8::StaticOrder>(lds, g, S, E, tid); }
        { pg8::Gemm g{BR + 512, Wbrt + 512, 256, 1024, 1024}; pg8::Epi3<1> E{Gt + 1024, TMP, MG}; pg8::gemm_phase<pg8::Epi3<1>, pg8::StaticOrder>(lds, g, S, E, tid); }
        { pg8::Gemm g{BR + 768, Wbrt + 768, 256, 1024, 1024}; pg8::Epi3<2> E{Gt + 2048, TMP, MG}; pg8::gemm_phase<pg8::Epi3<2>, pg8::StaticOrder>(lds, g, S, E, tid); }
    }
    xcd_barrier(bar); PHASE_ARGS();

    {
        pg8::Gemm g{MG, Woutt, 1024, 1024, 1024}; pg8::StaticOrder S; S.init(MT, 1024, G, bx);
        pg8::Epi4 E{x_prompt, x_sample, norm2_g, X1, A2, SS};
        pg8::gemm_phase<pg8::Epi4, pg8::StaticOrder>(lds, g, S, E, tid);
    }
    xcd_barrier(bar); PHASE_ARGS();

    {
        pg8::Gemm g{A2, Wgut, 1024, 1024, 1024}; pg8::StaticOrder S; S.init(MT, NGU, G, bx);
        pg8::Epi5 E{SS, GG, UU, out};
        pg8::gemm_phase<pg8::Epi5, pg8::StaticOrder>(lds, g, S, E, tid);
    }
    xcd_barrier(bar); PHASE_ARGS();

    {
        constexpr int CPR = DFF / 8;
        for (long idx = (long)bx * NTHR + tid; idx < (long)MT * CPR; idx += (long)G * NTHR) {
            const int row = (int)(idx / CPR), ch0 = (int)(idx % CPR) * 8;
            const u32x4 g0w = *(const u32x4*)(GG + (size_t)row * DFF + ch0), uw = *(const u32x4*)(UU + (size_t)row * DFF + ch0);
            float g0[8], g1[8], g2[8], uu[8];
            g0[0] = bflo(g0w.x); g0[1] = bfhi(g0w.x); g0[2] = bflo(g0w.y); g0[3] = bfhi(g0w.y); g0[4] = bflo(g0w.z); g0[5] = bfhi(g0w.z); g0[6] = bflo(g0w.w); g0[7] = bfhi(g0w.w);
            uu[0] = bflo(uw.x); uu[1] = bfhi(uw.x); uu[2] = bflo(uw.y); uu[3] = bfhi(uw.y); uu[4] = bflo(uw.z); uu[5] = bfhi(uw.z); uu[6] = bflo(uw.w); uu[7] = bfhi(uw.w);
            int tpos; bool smp = row >= MP; int sb = 0;
            if (!smp) tpos = row & (SEQ - 1); else { tpos = (row - MP) & 7; sb = (row - MP) >> 3; }
#pragma unroll
            for (int e = 0; e < 8; ++e) { g1[e] = 0.f; g2[e] = 0.f; }
            if (tpos >= 1) { const u32x4 w = *(const u32x4*)(GG + (size_t)(row - 1) * DFF + ch0);
                g1[0] = bflo(w.x); g1[1] = bfhi(w.x); g1[2] = bflo(w.y); g1[3] = bfhi(w.y); g1[4] = bflo(w.z); g1[5] = bfhi(w.z); g1[6] = bflo(w.w); g1[7] = bfhi(w.w); }
            else if (smp) { const float* sp = state_conv + ((size_t)sb * 2 + 1) * DFF + ch0;
#pragma unroll
                for (int e = 0; e < 8; ++e) g1[e] = sp[e]; }
            if (tpos >= 2) { const u32x4 w = *(const u32x4*)(GG + (size_t)(row - 2) * DFF + ch0);
                g2[0] = bflo(w.x); g2[1] = bfhi(w.x); g2[2] = bflo(w.y); g2[3] = bfhi(w.y); g2[4] = bflo(w.z); g2[5] = bfhi(w.z); g2[6] = bflo(w.w); g2[7] = bfhi(w.w); }
            else if (smp) { const float* sp = state_conv + ((size_t)sb * 2 + tpos) * DFF + ch0;
#pragma unroll
                for (int e = 0; e < 8; ++e) g2[e] = sp[e]; }
            float a[8];
#pragma unroll
            for (int e = 0; e < 8; ++e) { const int ch = ch0 + e;
                const float gc = conv_b[ch] + conv_w[ch] * g2[e] + conv_w[DFF + ch] * g1[e] + conv_w[2 * DFF + ch] * g0[e];
                const float z = 0.7978845608028654f * (gc + 0.044715f * gc * gc * gc);
                const float ge = gc * frcp(1.f + fexp2(-2.f * LOG2E * z));
                a[e] = ge * uu[e]; }
            u32x4 w; w.x = pk2(a[0], a[1]); w.y = pk2(a[2], a[3]); w.z = pk2(a[4], a[5]); w.w = pk2(a[6], a[7]);
            *(u32x4*)(ACT + (size_t)row * DFF + ch0) = w;
        }
    }
    xcd_barrier(bar); PHASE_ARGS();

    {
        pg8::Gemm g{ACT, Wdt, DFF, DFF, DFF}; pg8::StaticOrder S; S.init(MT, 1024, G, bx);
        pg8::Epi6 E{X1, X2};
        pg8::gemm_phase<pg8::Epi6, pg8::StaticOrder>(lds, g, S, E, tid);
    }
    xcd_barrier(bar); PHASE_ARGS();

    for (int m = gw; m < MT; m += NGW) {
        const f32x4* xr = (const f32x4*)(X2 + (size_t)m * D) + lane; const f32x4* gr = (const f32x4*)final_g + lane;
        f32x4 v[4]; float s = 0.f;
#pragma unroll
        for (int j = 0; j < 4; ++j) { v[j] = xr[64 * j]; s += (v[j][0] * v[j][0] + v[j][1] * v[j][1]) + (v[j][2] * v[j][2] + v[j][3] * v[j][3]); }
        const float rstd = frsq(wave_sum(s) * (1.f / 1024.f) + EPS);
        f32x4* o = (f32x4*)(out + (m < MP ? O_YP + (size_t)m * D : O_YS + (size_t)(m - MP) * D)) + lane;
#pragma unroll
        for (int j = 0; j < 4; ++j) o[64 * j] = v[j] * rstd * gr[64 * j];
    }
}

#undef ws
#undef out
extern "C" void kernel_launch(void* const* d_in, const int* in_sizes, int n_in, void* d_out, int out_size, void* d_ws, size_t ws_size, hipStream_t stream) {
    static int grid = 0;
    if (grid == 0) {
        if (n_in != 33 || (size_t)out_size != O_END || ws_size < WS_END) { fprintf(stderr, "kernel_launch: unexpected shapes (n_in %d, out %d, ws %zu)\n", n_in, out_size, ws_size); grid = -1; return; }
        int dev = 0, cus = 0;
        if (hipGetDevice(&dev) != hipSuccess || hipDeviceGetAttribute(&cus, hipDeviceAttributeMultiprocessorCount, dev) != hipSuccess) { grid = -1; return; }
        if (hipFuncSetAttribute((const void*)fwd_kernel, hipFuncAttributeMaxDynamicSharedMemorySize, LDS_BYTES) != hipSuccess) { fprintf(stderr, "kernel_launch: hipFuncSetAttribute failed\n"); grid = -1; return; }
        int per_cu = 0;
        if (hipOccupancyMaxActiveBlocksPerMultiprocessor(&per_cu, (const void*)fwd_kernel, NTHR, LDS_BYTES) != hipSuccess || per_cu < 1) fprintf(stderr, "kernel_launch: occupancy query reports %d\n", per_cu);
        (void)hipGetLastError();
        grid = cus;
    }
    if (grid < 0) return;
    if (hipMemsetAsync((char*)d_ws + WS_CTL, 0, CTL_ZERO_BYTES, stream) != hipSuccess) return;
    Args a{};
    for (int i = 0; i < 33; ++i) a.in[i] = d_in[i];
    a.out = (float*)d_out; a.ws = (unsigned char*)d_ws;
    hipLaunchKernelGGL(fwd_kernel, dim3(grid), dim3(NTHR), LDS_BYTES, stream, a);
}
```

```cpp
#include <hip/hip_runtime.h>
#include <cstdio>
#include <cstdint>

#define LAS __attribute__((address_space(3)))
#define GAS __attribute__((address_space(1)))
typedef unsigned short bf16;
typedef short bf16x8 __attribute__((ext_vector_type(8)));
typedef short s16x4 __attribute__((ext_vector_type(4)));
typedef float f32x4 __attribute__((ext_vector_type(4)));
typedef float f32x2 __attribute__((ext_vector_type(2)));
typedef unsigned u32x4 __attribute__((ext_vector_type(4)));
typedef unsigned u32x2 __attribute__((ext_vector_type(2)));
typedef GAS unsigned gu32;

constexpr int D = 1024, MP = 16384, MS = 1024, MT = MP + MS, MM = 2048, MA = MT + MM;
constexpr int SEQ = 2048, NB = 8, DB = 128, DS = 8, NPAGES = 16;
constexpr int DFF = 2816, NW1 = 5632, NGU = 5632;
constexpr float EPS = 1e-6f, LOG2E = 1.4426950408889634f, QSCALE = 0.125f * 1.4426950408889634f, NEGB = -1e30f;
constexpr float LAM_INIT = 0.2f;
constexpr size_t O_YP = 0, O_YS = 16777216, O_KP = 17825792, O_VP = 26214400, O_KS = 34603008, O_VS = 35127296,
                 O_POOLP = 35651584, O_POOLS = 35682304, O_CONVP = 36173824, O_CONVS = 36218880, O_MK = 36939776, O_MV = 37464064, O_END = 37988352;
constexpr size_t MiB = 1u << 20;
constexpr size_t WS_CTL = 0, CTL_ZERO_BYTES = 1 * MiB;
constexpr size_t WS_W1T = 2 * MiB, WS_WBR = 13 * MiB, WS_WOUT = 15 * MiB, WS_WGU = 17 * MiB, WS_WD = 28 * MiB;
constexpr size_t WS_XN = 34 * MiB, WS_QB = 72 * MiB, WS_KB = 89 * MiB, WS_VB = 106 * MiB, WS_QMB = 123 * MiB, WS_U = 132 * MiB, WS_G = 149 * MiB;
constexpr size_t WS_MKB = 251 * MiB, WS_MVB = 252 * MiB, WS_BR = 253 * MiB, WS_TMP = 287 * MiB, WS_MG = 355 * MiB, WS_X1 = 389 * MiB, WS_A2 = 457 * MiB;
constexpr size_t WS_SS = 491 * MiB, WS_GG = 493 * MiB, WS_UU = 587 * MiB, WS_ACT = 681 * MiB, WS_X2 = 775 * MiB, WS_END = 843 * MiB;
constexpr int CW_BAR = 4096;

typedef __bf16 bf16x2_t __attribute__((ext_vector_type(2)));
__device__ __forceinline__ unsigned pk2(float lo, float hi) { const f32x2 v = {lo, hi}; const bf16x2_t b = __builtin_convertvector(v, bf16x2_t); return __builtin_bit_cast(unsigned, b); }
__device__ __forceinline__ float bflo(unsigned w) { return __builtin_bit_cast(float, w << 16); }
__device__ __forceinline__ float bfhi(unsigned w) { return __builtin_bit_cast(float, w & 0xffff0000u); }
template <int CTRL> __device__ __forceinline__ float dppx(float v) { return __builtin_bit_cast(float, __builtin_amdgcn_update_dpp(0, __builtin_bit_cast(int, v), CTRL, 0xf, 0xf, true)); }
#define SWAP16(v, a, b) unsigned a = __builtin_bit_cast(unsigned, v), b = a; asm("" : "+v"(b)); { auto r_ = __builtin_amdgcn_permlane16_swap(a, b, false, false); a = r_[0]; b = r_[1]; }
#define SWAP32(v, a, b) unsigned a = __builtin_bit_cast(unsigned, v), b = a; asm("" : "+v"(b)); { auto r_ = __builtin_amdgcn_permlane32_swap(a, b, false, false); a = r_[0]; b = r_[1]; }
__device__ __forceinline__ float sum16(float v) { SWAP16(v, a, b); return __builtin_bit_cast(float, a) + __builtin_bit_cast(float, b); }
__device__ __forceinline__ float sum32(float v) { SWAP32(v, a, b); return __builtin_bit_cast(float, a) + __builtin_bit_cast(float, b); }
__device__ __forceinline__ float max16(float v) { SWAP16(v, a, b); return fmaxf(__builtin_bit_cast(float, a), __builtin_bit_cast(float, b)); }
__device__ __forceinline__ float max32(float v) { SWAP32(v, a, b); return fmaxf(__builtin_bit_cast(float, a), __builtin_bit_cast(float, b)); }
__device__ __forceinline__ float sum_g4(float v) { return sum32(sum16(v)); }
__device__ __forceinline__ float max_g4(float v) { return max32(max16(v)); }
__device__ __forceinline__ float wave_sum(float v) {
    v += dppx<0xB1>(v); v += dppx<0x4E>(v); v += dppx<0x141>(v); v += dppx<0x140>(v);
    return sum_g4(v);
}
__device__ __forceinline__ float fexp2(float x) { return __builtin_amdgcn_exp2f(x); }
__device__ __forceinline__ float frcp(float x) { return __builtin_amdgcn_rcpf(x); }
__device__ __forceinline__ float frsq(float x) { return __builtin_amdgcn_rsqf(x); }

namespace pg8 {
constexpr int BM = 256, BK = 64, HALF = 128, HTB = HALF * BK * 2, STAGE_BYTES = 8 * HTB, NXCD = 8, WGM = 8;
__host__ __device__ __forceinline__ int lds_byte(int r, int c) { const int st = (r >> 4) * 2 + (c >> 5), rr = r & 15, cc = c & 31, ob = rr * 64 + cc * 2; return st * 1024 + (ob ^ (((ob >> 9) & 1) << 5)); }
__host__ __device__ __forceinline__ void stage_rc(int b, int& R, int& C) { const int st = b / 1024, sb = b % 1024, swz = sb ^ (((sb >> 9) & 1) << 5); R = (st >> 1) * 16 + swz / 64; C = (st & 1) * 32 + (swz % 64) / 2; }
__host__ __device__ __forceinline__ int perm32(int rho) { const int n = rho >> 4, i = rho & 15; return 8 * (i >> 2) + 4 * n + (i & 3); }

struct Unit { int pm, pn, ko; };
struct Gemm { const bf16* A; const bf16* Bt; int K, lda, ldb; };

struct StaticOrder {
    int nM, nN, nwg, G, c;
    __device__ void init(int M, int N, int G_, int c_) { nM = M / BM; nN = N / BM; nwg = nM * nN; G = G_; c = c_; }
    __device__ bool next(int i, Unit& u) const {
        const long L = (long)i * G + c; if (L >= nwg) return false;
        int wgid = (int)L; { const int q = nwg / NXCD, r = nwg % NXCD, xcd = wgid % NXCD, off = wgid / NXCD; wgid = (xcd < r ? xcd * (q + 1) : r * (q + 1) + (xcd - r) * q) + off; }
        const int nig = WGM * nN, gid = wgid / nig, fm = gid * WGM, gsz = (nM - fm) < WGM ? (nM - fm) : WGM;
        u.pm = fm + ((wgid % nig) % gsz); u.pn = (wgid % nig) / gsz; u.ko = 0; return true;
    }
    __device__ __forceinline__ void a_ready(const Unit&) const {}
    __device__ __forceinline__ void done(const Unit&) const {}
};
struct Order1 {
    StaticOrder so; int G, c;
    __device__ void init(int G_, int c_) { so.init(MT, 5120, G_, c_); G = G_; c = c_; }
    __device__ bool next(int i, Unit& u) const {
        const long L = (long)i * G + c;
        if (L < so.nwg) return so.next(i, u);
        const int e = (int)(L - so.nwg); if (e >= 16) return false;
        u.pm = 68 + (e >> 1); u.pn = 20 + (e & 1); u.ko = 0; return true;
    }
    __device__ __forceinline__ void a_ready(const Unit&) const {}
    __device__ __forceinline__ void done(const Unit&) const {}
};

struct SplitOrder {
    int G, c, nitems, KC;
    __device__ void init(int nchunks, int KC_, int G_, int c_) { G = G_; c = c_; nitems = 16 * nchunks; KC = KC_; }
    __device__ bool next(int i, Unit& u) const { const long L = (long)i * G + c; if (L >= nitems) return false; const int j = (int)L & 15; u.pm = 64 + (j >> 2); u.pn = j & 3; u.ko = ((int)L >> 4) * KC; return true; }
    __device__ __forceinline__ void a_ready(const Unit&) const {}
    __device__ __forceinline__ void done(const Unit&) const {}
};

template <class Epi, class Sched>
__device__ __forceinline__ void gemm_phase(LAS unsigned char* lds, const Gemm g, const Sched& S, const Epi& E, const int tid) {
    const int wid = __builtin_amdgcn_readfirstlane(tid >> 6), lane = tid & 63, wr = wid >> 2, wc = wid & 3, fr = lane & 15, fq = lane >> 4;
    const int K = g.K, nt = K / BK;
    unsigned voffA[2], voffB[2];
#pragma unroll
    for (int i = 0; i < 2; ++i) { int R, C; stage_rc(tid * 16 + i * 8192, R, C); const int Rb = Epi::PERM ? ((R & ~31) + perm32(R & 31)) : R;
        voffA[i] = (unsigned)(R * g.lda + C) * 2u; voffB[i] = (unsigned)(Rb * g.ldb + C) * 2u; }
    const size_t kstep = (size_t)(BK * 2);
    const size_t hstepA = (size_t)HALF * g.lda * 2, hstepB = (size_t)HALF * g.ldb * 2;
    const size_t tstepA = 2 * hstepA, tstepB = 2 * hstepB;
    const unsigned ldsw = (unsigned)wid * 1024u;
    const int aoff = lds_byte(wr * 64 + fr, fq * 8), boff = lds_byte(wc * 32 + fr, fq * 8);
#define PG8_SA(b, h) (((b) * 2 + (h)) * HTB)
#define PG8_SB(b, h) ((4 + (b) * 2 + (h)) * HTB)
#define PG8_STAGE(bufoff, gbase, voff) do { _Pragma("unroll") for (int _i = 0; _i < 2; ++_i) \
        __builtin_amdgcn_global_load_lds((const unsigned*)((const char*)(gbase) + (voff)[_i]), (LAS unsigned*)(lds + (bufoff) + ldsw + _i * 8192), 16, 0, 0); } while (0)
#define PG8_LDA(dst, b, h) do { _Pragma("unroll") for (int m = 0; m < 4; ++m) _Pragma("unroll") for (int k = 0; k < 2; ++k) dst[m][k] = *(const LAS bf16x8*)(lds + PG8_SA(b, h) + aoff + m * 2048 + k * 1024); } while (0)
#define PG8_LDB(dst, b, h) do { _Pragma("unroll") for (int n = 0; n < 2; ++n) _Pragma("unroll") for (int k = 0; k < 2; ++k) dst[n][k] = *(const LAS bf16x8*)(lds + PG8_SB(b, h) + boff + n * 2048 + k * 1024); } while (0)
#define PG8_MMA(ai, bj, At, Bt) do { __builtin_amdgcn_s_setprio(1); _Pragma("unroll") for (int m = 0; m < 4; ++m) _Pragma("unroll") for (int n = 0; n < 2; ++n) _Pragma("unroll") for (int k = 0; k < 2; ++k) \
        acc[ai][bj][m][n] = __builtin_amdgcn_mfma_f32_16x16x32_bf16(Bt[n][k], At[m][k], acc[ai][bj][m][n], 0, 0, 0); __builtin_amdgcn_s_setprio(0); } while (0)
#define PG8_WAIT_V(n) asm volatile("s_waitcnt vmcnt(" #n ")" ::: "memory")
#define PG8_WAIT_L(n) asm volatile("s_waitcnt lgkmcnt(" #n ")" ::: "memory")
#define PG8_BAR __builtin_amdgcn_s_barrier()
#define PG8_SCHED __builtin_amdgcn_sched_barrier(0)
    Unit cur, nxt; int ui = 0;
    if (!S.next(0, cur)) return;
    f32x4 acc[2][2][4][2];
#pragma unroll
    for (int a = 0; a < 2; ++a)
#pragma unroll
        for (int b = 0; b < 2; ++b)
#pragma unroll
            for (int m = 0; m < 4; ++m)
#pragma unroll
                for (int n = 0; n < 2; ++n) acc[a][b][m][n] = (f32x4){0.f, 0.f, 0.f, 0.f};
    bf16x8 At[4][2], B0[2][2], B1[2][2];
    const char* cA = (const char*)g.A + (size_t)cur.pm * tstepA + (size_t)cur.ko * 2; const char* cB = (const char*)g.Bt + (size_t)cur.pn * tstepB + (size_t)cur.ko * 2;
    S.a_ready(cur);
    PG8_STAGE(PG8_SB(0, 0), cB, voffB); PG8_STAGE(PG8_SB(0, 1), cB + hstepB, voffB); PG8_STAGE(PG8_SA(0, 0), cA, voffA); PG8_STAGE(PG8_SA(0, 1), cA + hstepA, voffA);
    if (wr == 1) PG8_BAR;
    PG8_WAIT_V(2); PG8_BAR;
    PG8_STAGE(PG8_SB(1, 0), cB + kstep, voffB); PG8_STAGE(PG8_SA(1, 0), cA + kstep, voffA); PG8_STAGE(PG8_SB(1, 1), cB + hstepB + kstep, voffB);
    PG8_WAIT_V(6); PG8_BAR;
    for (;;) {
        const bool has_next = S.next(ui + 1, nxt);
        const char* nA = has_next ? (const char*)g.A + (size_t)nxt.pm * tstepA + (size_t)nxt.ko * 2 : cA; const char* nB = has_next ? (const char*)g.Bt + (size_t)nxt.pn * tstepB + (size_t)nxt.ko * 2 : cB;
        for (int t = 0; t < nt; t += 2) {
            const bool last = (t == nt - 2);
            const char* a1 = cA + (size_t)(t + 1) * kstep;
            const char* a2 = last ? nA : cA + (size_t)(t + 2) * kstep; const char* b2 = last ? nB : cB + (size_t)(t + 2) * kstep;
            const char* a3 = a2 + kstep; const char* b3 = b2 + kstep;
            if (last && has_next) S.a_ready(nxt);
            if constexpr (Epi::KHOOK) { if (t == Epi::KH0 || t == Epi::KH1) E.khook(acc, cur, t, wr, wc, fr, fq); }
            PG8_LDB(B0, 0, 0); PG8_LDB(B1, 0, 1); PG8_SCHED; PG8_LDA(At, 0, 0); PG8_STAGE(PG8_SA(1, 1), a1 + hstepA, voffA);
            PG8_WAIT_V(8); PG8_WAIT_L(0); PG8_BAR; PG8_MMA(0, 0, At, B0); PG8_MMA(0, 1, At, B1); PG8_BAR; PG8_SCHED;
            PG8_LDA(At, 0, 1); PG8_STAGE(PG8_SB(0, 0), b2, voffB); PG8_STAGE(PG8_SB(0, 1), b2 + hstepB, voffB); PG8_STAGE(PG8_SA(0, 0), a2, voffA);
            PG8_WAIT_V(8); PG8_WAIT_L(0); PG8_BAR; PG8_MMA(1, 0, At, B0); PG8_MMA(1, 1, At, B1); PG8_BAR; PG8_SCHED;
            PG8_LDB(B0, 1, 0); PG8_LDB(B1, 1, 1); PG8_SCHED; PG8_LDA(At, 1, 0); PG8_STAGE(PG8_SA(0, 1), a2 + hstepA, voffA);
            PG8_WAIT_V(8); PG8_WAIT_L(0); PG8_BAR; PG8_MMA(0, 0, At, B0); PG8_MMA(0, 1, At, B1); PG8_BAR; PG8_SCHED;
            PG8_LDA(At, 1, 1); PG8_STAGE(PG8_SB(1, 0), b3, voffB); PG8_STAGE(PG8_SB(1, 1), b3 + hstepB, voffB); PG8_STAGE(PG8_SA(1, 0), a3, voffA);
            PG8_WAIT_V(8); PG8_WAIT_L(0); PG8_BAR; PG8_MMA(1, 0, At, B0); PG8_MMA(1, 1, At, B1); PG8_BAR; PG8_SCHED;
        }
        if (wr == 0) PG8_BAR;
        E(acc, cur, wr, wc, fr, fq); S.done(cur);
        if (!has_next) break;
#pragma unroll
        for (int a = 0; a < 2; ++a)
#pragma unroll
            for (int b = 0; b < 2; ++b)
#pragma unroll
                for (int m = 0; m < 4; ++m)
#pragma unroll
                    for (int n = 0; n < 2; ++n) acc[a][b][m][n] = (f32x4){0.f, 0.f, 0.f, 0.f};
        cur = nxt; cA = nA; cB = nB; ++ui;
        if (wr == 1) PG8_BAR;
    }
    PG8_WAIT_V(0);
    PG8_BAR;
#undef PG8_SA
#undef PG8_SB
#undef PG8_STAGE
#undef PG8_LDA
#undef PG8_LDB
#undef PG8_MMA
#undef PG8_WAIT_V
#undef PG8_WAIT_L
#undef PG8_BAR
#undef PG8_SCHED
}

typedef f32x4 Acc[2][2][4][2];

struct Epi1 {
    static constexpr bool PERM = true, KHOOK = false;
    bf16 *Qb, *Kb, *Vb, *QMb, *G, *MKb, *MVb; float* U; float* out;
    __device__ __forceinline__ void operator()(const Acc& acc, const Unit& u, int wr, int wc, int fr, int fq) const {
        asm volatile("" : "+v"(fr), "+v"(fq));
        const int pn = u.pn, pm = u.pm;
        bf16* bd = nullptr; int bld = 0; float* fd = nullptr; int fld = 0; float sc = 1.f; bool sig = false;
        if (pm >= 68) { const size_t r0 = (size_t)(pm - 68) * 256; bld = 256; fld = 256;
            if (pn == 20) { bd = MKb + r0 * 256; fd = out + O_MK + r0 * 256; } else { bd = MVb + r0 * 256; fd = out + O_MV + r0 * 256; } }
        else {
            const bool smp = pm >= 64; const size_t r0 = (size_t)pm * 256, f0 = smp ? (size_t)(pm - 64) * 256 : r0;
            if (pn < 2) { bd = Qb + r0 * 512 + pn * 256; bld = 512; sc = QSCALE; }
            else if (pn < 4) { bd = Kb + r0 * 512 + (pn - 2) * 256; bld = 512; fd = out + (smp ? O_KS : O_KP) + f0 * 512 + (pn - 2) * 256; fld = 512; }
            else if (pn < 6) { bd = Vb + r0 * 512 + (pn - 4) * 256; bld = 512; fd = out + (smp ? O_VS : O_VP) + f0 * 512 + (pn - 4) * 256; fld = 512; }
            else if (pn == 6) { fd = U + r0 * 256; fld = 256; }
            else if (pn == 7) { bd = QMb + r0 * 256; bld = 256; sc = QSCALE; }
            else { bd = G + r0 * 3072 + (pn - 8) * 256; bld = 3072; sig = true; }
        }
        const int cl = wc * 32 + 8 * fq;
#pragma unroll
        for (int ai = 0; ai < 2; ++ai)
#pragma unroll
            for (int m = 0; m < 4; ++m) { const size_t rr = (size_t)(128 * ai + 64 * wr + 16 * m + fr);
#pragma unroll
                for (int bj = 0; bj < 2; ++bj) { f32x4 v0 = acc[ai][bj][m][0], v1 = acc[ai][bj][m][1];
                    if (fd) { float* p = fd + rr * fld + 128 * bj + cl; *(f32x4*)p = v0; *(f32x4*)(p + 4) = v1; }
                    if (bd) {
                        if (sig) {
#pragma unroll
                            for (int j = 0; j < 4; ++j) { v0[j] = frcp(1.f + fexp2(-LOG2E * v0[j])); v1[j] = frcp(1.f + fexp2(-LOG2E * v1[j])); } }
                        v0 = v0 * sc; v1 = v1 * sc;
                        u32x4 w; w.x = pk2(v0[0], v0[1]); w.y = pk2(v0[2], v0[3]); w.z = pk2(v1[0], v1[1]); w.w = pk2(v1[2], v1[3]);
                        *(u32x4*)(bd + rr * bld + 128 * bj + cl) = w; } } }
    }
};

struct Epi3 {
    static constexpr bool PERM = true, KHOOK = true; static constexpr int KH0 = 8, KH1 = 12;
    const bf16* G; bf16* MG;
    __device__ __forceinline__ void khook(Acc& acc, const Unit& u, int t, int wr, int wc, int fr, int fq) const {
        asm volatile("" : "+v"(fr), "+v"(fq));
        const size_t row0 = (size_t)u.pm * 256; const int col0 = u.pn * 256 + wc * 32 + 8 * fq + (t == KH0 ? 0 : 1024);
#pragma unroll
        for (int ai = 0; ai < 2; ++ai)
#pragma unroll
            for (int m = 0; m < 4; ++m) { const size_t r = row0 + (size_t)(128 * ai + 64 * wr + 16 * m + fr);
#pragma unroll
                for (int bj = 0; bj < 2; ++bj) { const bf16* gp = G + r * 3072 + col0 + 128 * bj;
                    const u32x4 nu = *(const u32x4*)gp, de = *(const u32x4*)(gp + 1024);
                    float rt[8];
                    rt[0] = bflo(nu.x) * frcp(fmaxf(bflo(de.x), 1e-20f)); rt[1] = bfhi(nu.x) * frcp(fmaxf(bfhi(de.x), 1e-20f));
                    rt[2] = bflo(nu.y) * frcp(fmaxf(bflo(de.y), 1e-20f)); rt[3] = bfhi(nu.y) * frcp(fmaxf(bfhi(de.y), 1e-20f));
                    rt[4] = bflo(nu.z) * frcp(fmaxf(bflo(de.z), 1e-20f)); rt[5] = bfhi(nu.z) * frcp(fmaxf(bfhi(de.z), 1e-20f));
                    rt[6] = bflo(nu.w) * frcp(fmaxf(bflo(de.w), 1e-20f)); rt[7] = bfhi(nu.w) * frcp(fmaxf(bfhi(de.w), 1e-20f));
#pragma unroll
                    for (int j = 0; j < 4; ++j) { acc[ai][bj][m][0][j] *= rt[j]; acc[ai][bj][m][1][j] *= rt[4 + j]; } }
                asm volatile("" ::: "memory"); }
    }
    __device__ __forceinline__ void operator()(const Acc& acc, const Unit& u, int wr, int wc, int fr, int fq) const {
        asm volatile("" : "+v"(fr), "+v"(fq));
        const size_t row0 = (size_t)u.pm * 256; const int col0 = u.pn * 256 + wc * 32 + 8 * fq;
#pragma unroll
        for (int ai = 0; ai < 2; ++ai)
#pragma unroll
            for (int m = 0; m < 4; ++m) { const size_t r = row0 + (size_t)(128 * ai + 64 * wr + 16 * m + fr);
#pragma unroll
                for (int bj = 0; bj < 2; ++bj) { const int c = col0 + 128 * bj;
                    const u32x4 gw = *(const u32x4*)(G + r * 3072 + 2048 + c);
                    f32x4 a0 = acc[ai][bj][m][0], a1 = acc[ai][bj][m][1];
                    a0[0] *= fmaxf(bflo(gw.x), 1e-20f); a0[1] *= fmaxf(bfhi(gw.x), 1e-20f); a0[2] *= fmaxf(bflo(gw.y), 1e-20f); a0[3] *= fmaxf(bfhi(gw.y), 1e-20f);
                    a1[0] *= fmaxf(bflo(gw.z), 1e-20f); a1[1] *= fmaxf(bfhi(gw.z), 1e-20f); a1[2] *= fmaxf(bflo(gw.w), 1e-20f); a1[3] *= fmaxf(bfhi(gw.w), 1e-20f);
                    u32x4 w; w.x = pk2(a0[0], a0[1]); w.y = pk2(a0[2], a0[3]); w.z = pk2(a1[0], a1[1]); w.w = pk2(a1[2], a1[3]); *(u32x4*)(MG + r * 1024 + c) = w; }
                asm volatile("" ::: "memory"); }
    }
};

struct Epi4 {
    static constexpr bool PERM = true, KHOOK = false;
    const float *xp, *xs, *g2; float* X1; bf16* A2; float* SS;
    __device__ __forceinline__ void operator()(const Acc& acc, const Unit& u, int wr, int wc, int fr, int fq) const {
        asm volatile("" : "+v"(fr), "+v"(fq));
        const int pm = u.pm, pn = u.pn; const size_t row0 = (size_t)pm * 256;
        const float* xsrc = pm >= 64 ? xs + (size_t)(pm - 64) * 256 * 1024 : xp + row0 * 1024;
        const int col0 = pn * 256 + wc * 32 + 8 * fq;
        f32x4 gg[2][2];
#pragma unroll
        for (int bj = 0; bj < 2; ++bj)
#pragma unroll
            for (int n = 0; n < 2; ++n) gg[bj][n] = *(const f32x4*)(g2 + col0 + 128 * bj + 4 * n);
#pragma unroll
        for (int ai = 0; ai < 2; ++ai)
#pragma unroll
            for (int m = 0; m < 4; ++m) { const size_t rr = (size_t)(128 * ai + 64 * wr + 16 * m + fr); float s = 0.f;
#pragma unroll
                for (int bj = 0; bj < 2; ++bj) { const int c = col0 + 128 * bj;
                    const float* xr = xsrc + rr * 1024 + c;
                    const f32x4 v0 = *(const f32x4*)xr + acc[ai][bj][m][0], v1 = *(const f32x4*)(xr + 4) + acc[ai][bj][m][1];
                    float* xo = X1 + (row0 + rr) * 1024 + c; *(f32x4*)xo = v0; *(f32x4*)(xo + 4) = v1;
                    s += (v0[0] * v0[0] + v0[1] * v0[1]) + (v0[2] * v0[2] + v0[3] * v0[3]) + (v1[0] * v1[0] + v1[1] * v1[1]) + (v1[2] * v1[2] + v1[3] * v1[3]);
                    const f32x4 h0 = v0 * gg[bj][0], h1 = v1 * gg[bj][1];
                    u32x4 w; w.x = pk2(h0[0], h0[1]); w.y = pk2(h0[2], h0[3]); w.z = pk2(h1[0], h1[1]); w.w = pk2(h1[2], h1[3]);
                    *(u32x4*)(A2 + (row0 + rr) * 1024 + c) = w; }
                s = sum_g4(s);
                if (fq == 0) SS[(row0 + rr) * 16 + pn * 4 + wc] = s;
                asm volatile("" ::: "memory"); }
    }
};

struct Epi5 {
    static constexpr bool PERM = true, KHOOK = false;
    const float* SS; bf16 *GG, *UU; float* out;
    __device__ __forceinline__ void operator()(const Acc& acc, const Unit& u, int wr, int wc, int fr, int fq) const {
        asm volatile("" : "+v"(fr), "+v"(fq));
        const size_t row0 = (size_t)u.pm * 256; const int ch0 = u.pn * 128 + wc * 32 + 8 * fq;
#pragma unroll
        for (int ai = 0; ai < 2; ++ai)
#pragma unroll
            for (int m = 0; m < 4; ++m) { const size_t r = row0 + (size_t)(128 * ai + 64 * wr + 16 * m + fr);
                const f32x4* sp = (const f32x4*)(SS + r * 16); const f32x4 s0 = sp[0], s1 = sp[1], s2 = sp[2], s3 = sp[3];
                const float ss = ((s0[0] + s0[1]) + (s0[2] + s0[3])) + ((s1[0] + s1[1]) + (s1[2] + s1[3])) + ((s2[0] + s2[1]) + (s2[2] + s2[3])) + ((s3[0] + s3[1]) + (s3[2] + s3[3]));
                const float rstd = frsq(ss * (1.f / 1024.f) + EPS);
                const f32x4 g0 = acc[ai][0][m][0] * rstd, g1 = acc[ai][0][m][1] * rstd, u0 = acc[ai][1][m][0] * rstd, u1 = acc[ai][1][m][1] * rstd;
                u32x4 w; w.x = pk2(g0[0], g0[1]); w.y = pk2(g0[2], g0[3]); w.z = pk2(g1[0], g1[1]); w.w = pk2(g1[2], g1[3]);
                *(u32x4*)(GG + r * DFF + ch0) = w;
                w.x = pk2(u0[0], u0[1]); w.y = pk2(u0[2], u0[3]); w.z = pk2(u1[0], u1[1]); w.w = pk2(u1[2], u1[3]);
                *(u32x4*)(UU + r * DFF + ch0) = w;
                const int ri = (int)r;
                if (ri < MP) { const int t = ri & (SEQ - 1); if (t >= SEQ - 2) { float* p = out + O_CONVP + ((size_t)(ri >> 11) * 2 + (t - (SEQ - 2))) * DFF + ch0; *(f32x4*)p = g0; *(f32x4*)(p + 4) = g1; } }
                else { const int rs = ri - MP, q = rs & 7; if (q >= 6) { float* p = out + O_CONVS + ((size_t)(rs >> 3) * 2 + (q - 6)) * DFF + ch0; *(f32x4*)p = g0; *(f32x4*)(p + 4) = g1; } }
                asm volatile("" ::: "memory"); }
    }
};

struct Epi6 {
    static constexpr bool PERM = true, KHOOK = false;
    const float* X1; float* X2;
    __device__ __forceinline__ void operator()(const Acc& acc, const Unit& u, int wr, int wc, int fr, int fq) const {
        asm volatile("" : "+v"(fr), "+v"(fq));
        const size_t row0 = (size_t)u.pm * 256; const int col0 = u.pn * 256 + wc * 32 + 8 * fq;
#pragma unroll
        for (int ai = 0; ai < 2; ++ai)
#pragma unroll
            for (int m = 0; m < 4; ++m) { const size_t r = row0 + (size_t)(128 * ai + 64 * wr + 16 * m + fr);
#pragma unroll
                for (int bj = 0; bj < 2; ++bj) { const size_t o = r * 1024 + col0 + 128 * bj;
                    const f32x4 v0 = *(const f32x4*)(X1 + o) + acc[ai][bj][m][0], v1 = *(const f32x4*)(X1 + o + 4) + acc[ai][bj][m][1];
                    *(f32x4*)(X2 + o) = v0; *(f32x4*)(X2 + o + 4) = v1; }
                asm volatile("" ::: "memory"); }
    }
};
struct EpiPart {
    static constexpr bool PERM = true, KHOOK = false;
    float* PART; int KC;
    __device__ __forceinline__ void operator()(const Acc& acc, const Unit& u, int wr, int wc, int fr, int fq) const {
        asm volatile("" : "+v"(fr), "+v"(fq));
        float* base = PART + ((size_t)(u.ko / KC) * MS + (size_t)(u.pm - 64) * 256) * 1024 + u.pn * 256 + wc * 32 + 8 * fq;
#pragma unroll
        for (int ai = 0; ai < 2; ++ai)
#pragma unroll
            for (int m = 0; m < 4; ++m) { float* rp = base + (size_t)(128 * ai + 64 * wr + 16 * m + fr) * 1024;
#pragma unroll
                for (int bj = 0; bj < 2; ++bj) { *(f32x4*)(rp + 128 * bj) = acc[ai][bj][m][0]; *(f32x4*)(rp + 128 * bj + 4) = acc[ai][bj][m][1]; } }
    }
};
}

#define XB_TMO      128
#define XB_XCNT(j)  (256  + 64 * (j))
#define XB_XSUB(j)  (1280 + 64 * (j))
#define XB_XGEN(j)  (2304 + 64 * (j))
#define XB_TOP      3328
#define XB_TOPGEN   3392
#define XCD_BAR_WORDS 3456
#define XB_SPIN_CAP (1u << 18)
__device__ __forceinline__ unsigned xb_ld(unsigned* p)              { return __hip_atomic_load(p, __ATOMIC_RELAXED, __HIP_MEMORY_SCOPE_AGENT); }
__device__ __forceinline__ unsigned xb_add(unsigned* p, unsigned v) { return __hip_atomic_fetch_add(p, v, __ATOMIC_RELAXED, __HIP_MEMORY_SCOPE_AGENT); }
__device__ __forceinline__ unsigned xb_xcc_id() { return (unsigned)__builtin_amdgcn_s_getreg((3 << 11) | 20) & 0xFu; }
#define XB_SPIN(cond, bar) do { unsigned _sp = 0; while (cond) { __builtin_amdgcn_s_sleep(1); \
    if ((++_sp & 255u) == 0u) { if (xb_ld(&(bar)[XB_TMO])) break; if (_sp > XB_SPIN_CAP) { atomicAdd(&(bar)[XB_TMO], 1u); break; } } } } while (0)
struct XcdBarrier { unsigned* bar; unsigned x; volatile LAS unsigned* st; };
__device__ __forceinline__ XcdBarrier xcd_barrier_post(unsigned* bar, volatile LAS unsigned* st) {
    XcdBarrier b; b.bar = bar; b.x = xb_xcc_id(); b.st = st;
    if (threadIdx.x == 0) (void)xb_add(&bar[XB_XCNT(b.x)], 1u);
    return b;
}
__device__ __forceinline__ void xcd_barrier_complete(unsigned* bar, unsigned x, unsigned& nloc, unsigned& nx) {
    const unsigned G = gridDim.x * gridDim.y * gridDim.z;
    unsigned sum, cnt, mine, sp = 0u;
    for (;;) {
        sum = 0u; cnt = 0u; mine = 0u;
#pragma unroll
        for (unsigned j = 0; j < 16; ++j) { const unsigned c = xb_ld(&bar[XB_XCNT(j)]); sum += c; cnt += (c > 0u) ? 1u : 0u; mine = (j == x) ? c : mine; }
        if (sum == G) break;
        __builtin_amdgcn_s_sleep(1);
        if ((++sp & 255u) == 0u) { if (xb_ld(&bar[XB_TMO])) break; if (sp > XB_SPIN_CAP) { atomicAdd(&bar[XB_TMO], 1u); break; } }
    }
    nloc = mine > 0u ? mine : 1u; nx = cnt > 0u ? cnt : 1u;
}
__device__ __forceinline__ void xcd_barrier(const XcdBarrier& b) {
    asm volatile("s_waitcnt vmcnt(0)" ::: "memory");
    __syncthreads();
    if (threadIdx.x == 0) {
        unsigned* bar = b.bar;
        __builtin_amdgcn_s_waitcnt(0);
        unsigned nloc = b.st[0], nx = b.st[1];
        if (nloc == 0u) { xcd_barrier_complete(bar, b.x, nloc, nx); b.st[0] = nloc; b.st[1] = nx; }
        const unsigned old = xb_add(&bar[XB_XSUB(b.x)], 1u);
        const unsigned gen = old / nloc;
        if (old + 1u == (gen + 1u) * nloc) {
            __builtin_amdgcn_fence(__ATOMIC_RELEASE, "agent");
            asm volatile("s_waitcnt vmcnt(0)" ::: "memory");
            const unsigned og = xb_add(&bar[XB_TOP], 1u);
            const unsigned tg = og / nx;
            if (og + 1u == (tg + 1u) * nx) xb_add(&bar[XB_TOPGEN], 1u);
            else XB_SPIN(xb_ld(&bar[XB_TOPGEN]) == tg, bar);
            __builtin_amdgcn_fence(__ATOMIC_ACQUIRE, "agent");
            xb_add(&bar[XB_XGEN(b.x)], 1u);
            asm volatile("s_waitcnt vmcnt(0)" ::: "memory");
        } else {
            XB_SPIN(xb_ld(&bar[XB_XGEN(b.x)]) == gen, bar);
            __builtin_amdgcn_fence(__ATOMIC_ACQUIRE, "agent");
            asm volatile("s_waitcnt vmcnt(0)" ::: "memory");
        }
    }
    __syncthreads();
}

constexpr int NWAVES = 8, NTHR = 512;
constexpr int RING_BYTES = 131072, LDSCTL_OFF = RING_BYTES, MISC_OFF = LDSCTL_OFF + 320, LDS_BYTES = 147456;
struct Args { const void* in[33]; float* out; unsigned char* ws; };

__device__ __forceinline__ void p0_transpose_item(const float* W, int N, bf16* WT, int ldt, int koff, int row_off, int mode, LAS float* scr, int item, int lane) {
    const int nblk = N / 32, kb = item / nblk, nb = item % nblk, k0 = 64 * kb, n0 = 32 * nb;
#pragma unroll 8
    for (int i = 0; i < 32; ++i) { const int kk = 2 * i + (lane >> 5); scr[kk * 33 + (lane & 31)] = W[(size_t)(k0 + kk) * N + n0 + (lane & 31)]; }
    asm volatile("s_waitcnt lgkmcnt(0)" ::: "memory");
    const int c = lane & 7;
    const int rbase = mode == 0 ? row_off + n0 : (256 * (n0 >> 7) + (n0 & 127) + (mode == 2 ? 128 : 0));
#pragma unroll
    for (int j = 0; j < 4; ++j) { const int n = (lane >> 3) + 8 * j; const LAS float* s = scr + (8 * c) * 33 + n;
        u32x4 o; o.x = pk2(s[0 * 33], s[1 * 33]); o.y = pk2(s[2 * 33], s[3 * 33]); o.z = pk2(s[4 * 33], s[5 * 33]); o.w = pk2(s[6 * 33], s[7 * 33]);
        *(u32x4*)(WT + (size_t)(rbase + n) * ldt + koff + k0 + 8 * c) = o; }
    asm volatile("s_waitcnt lgkmcnt(0)" ::: "memory");
}
__device__ __forceinline__ void rms_row_to_bf16(const float* xrow, const float* gain, bf16* orow, int lane) {
    const f32x4* xr = (const f32x4*)xrow + lane; const f32x4* gr = (const f32x4*)gain + lane;
    f32x4 v[4]; float s = 0.f;
#pragma unroll
    for (int j = 0; j < 4; ++j) { v[j] = xr[64 * j]; s += (v[j][0] * v[j][0] + v[j][1] * v[j][1]) + (v[j][2] * v[j][2] + v[j][3] * v[j][3]); }
    const float rstd = frsq(wave_sum(s) * (1.f / 1024.f) + EPS);
    u32x2* o8 = (u32x2*)orow + lane;
#pragma unroll
    for (int j = 0; j < 4; ++j) { const f32x4 gv = gr[64 * j]; u32x2 w; w.x = pk2(v[j][0] * rstd * gv[0], v[j][1] * rstd * gv[1]); w.y = pk2(v[j][2] * rstd * gv[2], v[j][3] * rstd * gv[3]); o8[64 * j] = w; }
}

template <int NMAP, int VD, bool CAUSAL>
__device__ __forceinline__ void flash_unit(LAS unsigned char* kv, const LAS float* T2h, const bf16* Qp, int qld, const bf16* Kp, int kld, const bf16* Vp, int vld,
                                           int NT, int qpos0, f32x4 (&O)[NMAP][VD / 16], float (&lsum)[NMAP], int tid, int wave, int lane) {
    constexpr int KROW = NMAP * 128, KPITCH = KROW + 32, VROW = VD * 2, VPITCH = VROW + 32, KBYTES = 64 * KPITCH, VBYTES = 64 * VPITCH, STG = KBYTES + VBYTES;
    constexpr int KCPR = KROW / 16, VCPR = VROW / 16, NKC = 64 * KCPR / NTHR, NVC = 64 * VCPR / NTHR, NDG = VD / 16;
    const int l16 = lane & 15, g = lane >> 4;
    bf16x8 qf[NMAP][2];
#pragma unroll
    for (int c = 0; c < NMAP; ++c)
#pragma unroll
        for (int ks = 0; ks < 2; ++ks) qf[c][ks] = *(const bf16x8*)(Qp + (size_t)(16 * wave + l16) * qld + c * 64 + ks * 32 + g * 8);
    float mrow[NMAP];
#pragma unroll
    for (int c = 0; c < NMAP; ++c) { mrow[c] = NEGB; lsum[c] = 0.f;
#pragma unroll
        for (int dg = 0; dg < NDG; ++dg) O[c][dg] = (f32x4){0.f, 0.f, 0.f, 0.f}; }
    u32x4 kr[NKC], vr[NVC];
    int krow[NKC], kch[NKC], vrow[NVC], vch[NVC];
#pragma unroll
    for (int i = 0; i < NKC; ++i) { const int idx = tid + i * NTHR; krow[i] = idx / KCPR; kch[i] = idx % KCPR; }
#pragma unroll
    for (int i = 0; i < NVC; ++i) { const int idx = tid + i * NTHR; vrow[i] = idx / VCPR; vch[i] = idx % VCPR; }
#define FL_GLOAD(t) do { _Pragma("unroll") for (int i = 0; i < NKC; ++i) kr[i] = *(const u32x4*)(Kp + (size_t)(64 * (t) + krow[i]) * kld + kch[i] * 8); \
                         _Pragma("unroll") for (int i = 0; i < NVC; ++i) vr[i] = *(const u32x4*)(Vp + (size_t)(64 * (t) + vrow[i]) * vld + vch[i] * 8); } while (0)
#define FL_LSTORE(buf) do { _Pragma("unroll") for (int i = 0; i < NKC; ++i) *(LAS u32x4*)(kv + (buf) * STG + krow[i] * KPITCH + kch[i] * 16) = kr[i]; \
                            _Pragma("unroll") for (int i = 0; i < NVC; ++i) *(LAS u32x4*)(kv + (buf) * STG + KBYTES + vrow[i] * VPITCH + vch[i] * 16) = vr[i]; } while (0)
    FL_GLOAD(0); FL_LSTORE(0);
    __syncthreads();
    const int qw0 = qpos0 + 16 * wave;
    for (int t = 0; t < NT; ++t) {
        const int buf = t & 1;
        if (t + 1 < NT) FL_GLOAD(t + 1);
        if (!CAUSAL || 64 * t <= qw0 + 15) {
            const LAS unsigned char* Kt = kv + buf * STG; const LAS unsigned char* Vt = Kt + KBYTES;
            f32x4 S[NMAP][4];
#pragma unroll
            for (int c = 0; c < NMAP; ++c)
#pragma unroll
                for (int kg = 0; kg < 4; ++kg) { f32x4 a = (f32x4){0.f, 0.f, 0.f, 0.f};
#pragma unroll
                    for (int ks = 0; ks < 2; ++ks) { const bf16x8 kf = *(const LAS bf16x8*)(Kt + (16 * kg + l16) * KPITCH + c * 128 + ks * 64 + g * 16);
                        a = __builtin_amdgcn_mfma_f32_16x16x32_bf16(kf, qf[c][ks], a, 0, 0, 0); }
                    S[c][kg] = a; }
            if (CAUSAL) {
                if (qw0 - (64 * t + 63) >= 128) { const float bfar = T2h[255];
#pragma unroll
                    for (int c = 0; c < NMAP; ++c)
#pragma unroll
                        for (int kg = 0; kg < 4; ++kg) S[c][kg] = S[c][kg] + bfar;
                } else {
#pragma unroll
                    for (int kg = 0; kg < 4; ++kg)
#pragma unroll
                        for (int i = 0; i < 4; ++i) { const int rel = (qw0 + l16) - (64 * t + 16 * kg + 4 * g + i); const float bb = T2h[rel < 0 ? 0 : (rel > 255 ? 255 : rel)];
#pragma unroll
                            for (int c = 0; c < NMAP; ++c) S[c][kg][i] = rel < 0 ? NEGB : S[c][kg][i] + bb; }
                }
            }
            bf16x8 pf[NMAP][2];
#pragma unroll
            for (int c = 0; c < NMAP; ++c) {
                float mx = S[c][0][0];
#pragma unroll
                for (int kg = 0; kg < 4; ++kg)
#pragma unroll
                    for (int i = 0; i < 4; ++i) mx = fmaxf(mx, S[c][kg][i]);
                mx = max_g4(mx);
                const float mn = fmaxf(mrow[c], mx), alpha = fexp2(mrow[c] - mn); mrow[c] = mn;
                float ps = 0.f;
#pragma unroll
                for (int kg = 0; kg < 4; ++kg)
#pragma unroll
                    for (int i = 0; i < 4; ++i) { const float p = fexp2(S[c][kg][i] - mn); S[c][kg][i] = p; ps += p; }
                lsum[c] = lsum[c] * alpha + ps;
#pragma unroll
                for (int dg = 0; dg < NDG; ++dg) O[c][dg] = O[c][dg] * alpha;
#pragma unroll
                for (int s = 0; s < 2; ++s) { u32x4 w; w.x = pk2(S[c][2 * s][0], S[c][2 * s][1]); w.y = pk2(S[c][2 * s][2], S[c][2 * s][3]);
                    w.z = pk2(S[c][2 * s + 1][0], S[c][2 * s + 1][1]); w.w = pk2(S[c][2 * s + 1][2], S[c][2 * s + 1][3]); pf[c][s] = __builtin_bit_cast(bf16x8, w); }
            }
#pragma unroll
            for (int dg = 0; dg < NDG; ++dg)
#pragma unroll
                for (int s = 0; s < 2; ++s) {
                    const LAS unsigned char* vp = Vt + (32 * s + 4 * g + (l16 >> 2)) * VPITCH + dg * 32 + (l16 & 3) * 8;
                    const s16x4 lo = __builtin_bit_cast(s16x4, __builtin_amdgcn_ds_read_tr16_b64_v4i16((LAS s16x4*)vp));
                    const s16x4 hi = __builtin_bit_cast(s16x4, __builtin_amdgcn_ds_read_tr16_b64_v4i16((LAS s16x4*)(vp + 16 * VPITCH)));
                    const bf16x8 vf = (bf16x8){lo[0], lo[1], lo[2], lo[3], hi[0], hi[1], hi[2], hi[3]};
#pragma unroll
                    for (int c = 0; c < NMAP; ++c) O[c][dg] = __builtin_amdgcn_mfma_f32_16x16x32_bf16(vf, pf[c][s], O[c][dg], 0, 0, 0);
                }
        }
        if (t + 1 < NT) FL_LSTORE(buf ^ 1);
        __syncthreads();
    }
#pragma unroll
    for (int c = 0; c < NMAP; ++c) { lsum[c] = sum_g4(lsum[c]); }
#undef FL_GLOAD
#undef FL_LSTORE
}

template <bool DIFF>
__device__ __forceinline__ void decode_item(LAS unsigned char* sm, const LAS float* T2h, int b, int h, const float* Kc, const float* Vc, const int* ptab,
                                            const bf16* Qrows  , int qld, const bf16* Knew, const bf16* Vnew  ,
                                            float lam, const float* subg, bf16* outp  , int tid, int wave, int lane) {
    constexpr int NG = DIFF ? 16 : 2, NKS = DIFF ? 4 : 2, NDG = DIFF ? 8 : 4, NS = NG / 2, VD = NDG * 16;
    asm volatile("" : "+v"(lane));
    const int l16 = lane & 15, g = lane >> 4, qn = l16 & 7, cn = l16 >> 3;
    bf16x8 qf[NKS];
#pragma unroll
    for (int ks = 0; ks < NKS; ++ks) {
        const bool on = DIFF ? (cn == (ks >> 1)) : (cn == 0);
        const bf16x8 z = (bf16x8){0, 0, 0, 0, 0, 0, 0, 0};
        const bf16x8 v = *(const bf16x8*)(Qrows + (size_t)qn * qld + 32 * ks + 8 * g);
        qf[ks] = on ? v : z;
    }
    int phys[2] = {0, 0};
    if (DIFF) { phys[0] = ptab[b * NPAGES + 2 * wave]; phys[1] = ptab[b * NPAGES + 2 * wave + 1]; }
    f32x4 S[NG + 1];
    f32x4 kb[2][2 * NKS];
#define DEC_KPTR(gi) (DIFF ? Kc + ((size_t)phys[(gi) >> 3] * 128 + 16 * ((gi) & 7) + l16) * 512 + h * 128 + 8 * g \
                           : Kc + ((size_t)(b * 256 + 32 * wave + 16 * (gi) + l16) * 4 + h) * 64 + 8 * g)
#define DEC_KLOAD(gi, dst) do { const float* kp_ = DEC_KPTR(gi); _Pragma("unroll") for (int ks = 0; ks < NKS; ++ks) { dst[2 * ks] = *(const f32x4*)(kp_ + 32 * ks); dst[2 * ks + 1] = *(const f32x4*)(kp_ + 32 * ks + 4); } } while (0)
    DEC_KLOAD(0, kb[0]);
#pragma unroll
    for (int gi = 0; gi < NG; ++gi) {
        if (gi + 1 < NG) DEC_KLOAD(gi + 1, kb[(gi + 1) & 1]);
        asm volatile("" ::: "memory");
        f32x4 a = (f32x4){0.f, 0.f, 0.f, 0.f};
#pragma unroll
        for (int ks = 0; ks < NKS; ++ks) { const f32x4 x0 = kb[gi & 1][2 * ks], x1 = kb[gi & 1][2 * ks + 1];
            u32x4 w; w.x = pk2(x0[0], x0[1]); w.y = pk2(x0[2], x0[3]); w.z = pk2(x1[0], x1[1]); w.w = pk2(x1[2], x1[3]);
            a = __builtin_amdgcn_mfma_f32_16x16x32_bf16(__builtin_bit_cast(bf16x8, w), qf[ks], a, 0, 0, 0); }
        S[gi] = a;
    }
#undef DEC_KLOAD
#undef DEC_KPTR
    S[NG] = (f32x4){NEGB, NEGB, NEGB, NEGB};
    if (DIFF) {
#pragma unroll
        for (int gi = 0; gi < NG; ++gi) {
            if (wave < 7 || gi < 8) { const float bfar = T2h[255]; S[gi] = S[gi] + bfar; }
            else {
#pragma unroll
                for (int i = 0; i < 4; ++i) { int rel = 2048 + qn - (256 * wave + 16 * gi + 4 * g + i); rel = rel > 255 ? 255 : rel; S[gi][i] += T2h[rel]; } }
        }
        if (wave == 0) {
            const int jr = l16 < 8 ? l16 : 7;
            f32x4 a = (f32x4){0.f, 0.f, 0.f, 0.f};
#pragma unroll
            for (int ks = 0; ks < NKS; ++ks) { const bf16x8 kf = *(const bf16x8*)(Knew + (size_t)jr * 512 + 32 * ks + 8 * g);
                a = __builtin_amdgcn_mfma_f32_16x16x32_bf16(kf, qf[ks], a, 0, 0, 0); }
#pragma unroll
            for (int i = 0; i < 4; ++i) { const int j = 4 * g + i; const int rel = qn - j; a[i] = (j < 8 && rel >= 0) ? a[i] + T2h[rel < 0 ? 0 : rel] : NEGB; }
            S[NG] = a;
        }
    }
    float mx = S[0][0];
#pragma unroll
    for (int gi = 0; gi < NG + 1; ++gi) { if (gi == NG && !DIFF) continue;
#pragma unroll
        for (int i = 0; i < 4; ++i) mx = fmaxf(mx, S[gi][i]); }
    mx = max_g4(mx);
    float ps = 0.f;
#pragma unroll
    for (int gi = 0; gi < NG + 1; ++gi) { if (gi == NG && !DIFF) continue;
#pragma unroll
        for (int i = 0; i < 4; ++i) { const float p = fexp2(S[gi][i] - mx); S[gi][i] = p; ps += p; } }
    ps = sum_g4(ps);
    f32x4 O[NDG];
#pragma unroll
    for (int dg = 0; dg < NDG; ++dg) O[dg] = (f32x4){0.f, 0.f, 0.f, 0.f};
    constexpr int VRS = DIFF ? 512 : 256;
    constexpr int NVB = NS * (NDG / 4);
    float vb[2][32];
#define DEC_VPTR(s) (DIFF ? Vc + ((size_t)phys[(s) >> 2] * 128 + 32 * ((s) & 3) + 4 * g) * 512 + h * 128 + l16 \
                          : Vc + ((size_t)(b * 256 + 32 * wave + 4 * g) * 4 + h) * 64 + l16)
#define DEC_VLOAD(bt, dst) do { const float* vp_ = DEC_VPTR((bt) / (NDG / 4)) + 64 * ((bt) % (NDG / 4)); _Pragma("unroll") for (int d4 = 0; d4 < 4; ++d4) _Pragma("unroll") for (int j = 0; j < 4; ++j) { \
        dst[8 * d4 + j] = vp_[(size_t)j * VRS + 16 * d4]; dst[8 * d4 + 4 + j] = vp_[(size_t)(16 + j) * VRS + 16 * d4]; } } while (0)
    DEC_VLOAD(0, vb[0]);
#pragma unroll
    for (int bt = 0; bt < NVB; ++bt) {
        if (bt + 1 < NVB) DEC_VLOAD(bt + 1, vb[(bt + 1) & 1]);
        asm volatile("" ::: "memory");
        const int s = bt / (NDG / 4), dgh = bt % (NDG / 4);
        u32x4 pw; pw.x = pk2(S[2 * s][0], S[2 * s][1]); pw.y = pk2(S[2 * s][2], S[2 * s][3]); pw.z = pk2(S[2 * s + 1][0], S[2 * s + 1][1]); pw.w = pk2(S[2 * s + 1][2], S[2 * s + 1][3]);
        const bf16x8 pf = __builtin_bit_cast(bf16x8, pw);
#pragma unroll
        for (int d4 = 0; d4 < 4; ++d4) { const float* x = &vb[bt & 1][8 * d4];
            u32x4 w; w.x = pk2(x[0], x[1]); w.y = pk2(x[2], x[3]); w.z = pk2(x[4], x[5]); w.w = pk2(x[6], x[7]);
            O[4 * dgh + d4] = __builtin_amdgcn_mfma_f32_16x16x32_bf16(__builtin_bit_cast(bf16x8, w), pf, O[4 * dgh + d4], 0, 0, 0); }
    }
#undef DEC_VLOAD
#undef DEC_VPTR
    if (DIFF && wave == 0) {
        u32x4 pw; pw.x = pk2(S[NG][0], S[NG][1]); pw.y = pk2(S[NG][2], S[NG][3]); pw.z = 0u; pw.w = 0u;
        const bf16x8 pf = __builtin_bit_cast(bf16x8, pw);
#pragma unroll
        for (int dg = 0; dg < NDG; ++dg) {
            unsigned short x[4];
#pragma unroll
            for (int j = 0; j < 4; ++j) { int kj = 4 * g + j; kj = kj < 8 ? kj : 7; x[j] = Vnew[(size_t)kj * 512 + 16 * dg + l16]; }
            u32x4 w; w.x = (unsigned)x[0] | ((unsigned)x[1] << 16); w.y = (unsigned)x[2] | ((unsigned)x[3] << 16); w.z = 0u; w.w = 0u;
            O[dg] = __builtin_amdgcn_mfma_f32_16x16x32_bf16(__builtin_bit_cast(bf16x8, w), pf, O[dg], 0, 0, 0);
        }
    }
    LAS float* OC = (LAS float*)sm; LAS float* ML = (LAS float*)(sm + 8 * 16 * VD * 4);
#pragma unroll
    for (int dg = 0; dg < NDG; ++dg) *(LAS f32x4*)(OC + (wave * 16 + l16) * VD + 16 * dg + 4 * g) = O[dg];
    if (g == 0) { ML[(wave * 16 + l16) * 2] = mx; ML[(wave * 16 + l16) * 2 + 1] = ps; }
    __syncthreads();
    {
        constexpr int DPL = VD / 64;
        const int q = wave;
        float o[DPL];
#pragma unroll
        for (int e = 0; e < DPL; ++e) o[e] = 0.f;
#pragma unroll
        for (int c = 0; c < (DIFF ? 2 : 1); ++c) { const int n = c * 8 + q;
            float M = NEGB;
#pragma unroll
            for (int w = 0; w < 8; ++w) M = fmaxf(M, ML[(w * 16 + n) * 2]);
            float L = 0.f, acc[DPL];
#pragma unroll
            for (int e = 0; e < DPL; ++e) acc[e] = 0.f;
#pragma unroll
            for (int w = 0; w < 8; ++w) { const float f = fexp2(ML[(w * 16 + n) * 2] - M); L += ML[(w * 16 + n) * 2 + 1] * f;
#pragma unroll
                for (int e = 0; e < DPL; ++e) acc[e] += OC[(w * 16 + n) * VD + DPL * lane + e] * f; }
            const float il = 1.f / L;
#pragma unroll
            for (int e = 0; e < DPL; ++e) o[e] += (c == 0 ? 1.f : -lam) * acc[e] * il;
        }
        if (DIFF) {
            const float ss = wave_sum(o[0] * o[0] + o[DPL - 1] * o[DPL - 1]);
            const float r = frsq(ss * (1.f / 128.f) + EPS) * (1.f - LAM_INIT);
            const unsigned w = pk2(o[0] * r * subg[DPL * lane], o[DPL - 1] * r * subg[DPL * lane + DPL - 1]);
            *(unsigned*)(outp + (size_t)q * 1024 + 2 * lane) = w;
        } else {
            const unsigned short v = (unsigned short)(pk2(o[0], 0.f) & 0xffffu);
            outp[(size_t)q * 1024 + lane] = v;
        }
    }
    __syncthreads();
}

#define x_prompt ((const float*)KA(0))
#define x_sample ((const float*)KA(1))
#define mem_prompt ((const float*)KA(2))
#define cache_k ((const float*)KA(3))
#define cache_v ((const float*)KA(4))
#define page_table ((const int*)KA(5))
#define state_pool ((const float*)KA(6))
#define state_conv ((const float*)KA(7))
#define cache_mem_k ((const float*)KA(8))
#define cache_mem_v ((const float*)KA(9))
#define norm1_g ((const float*)KA(10))
#define w_in ((const float*)KA(11))
#define lam_q1 ((const float*)KA(12))
#define lam_k1 ((const float*)KA(13))
#define lam_q2 ((const float*)KA(14))
#define lam_k2 ((const float*)KA(15))
#define subln_g ((const float*)KA(16))
#define w_pool_grp ((const float*)KA(17))
#define pool_scale ((const float*)KA(18))
#define w_br_attn ((const float*)KA(19))
#define w_br_pool ((const float*)KA(20))
#define w_br_mem ((const float*)KA(21))
#define mem_norm_g ((const float*)KA(22))
#define w_mem_kv ((const float*)KA(23))
#define w_out ((const float*)KA(24))
#define norm2_g ((const float*)KA(25))
#define w_ffn_gate ((const float*)KA(26))
#define w_ffn_up ((const float*)KA(27))
#define conv_w ((const float*)KA(28))
#define conv_b ((const float*)KA(29))
#define w_ffn_down ((const float*)KA(30))
#define rel_bias ((const float*)KA(31))
#define final_g ((const float*)KA(32))
#define W1t ((bf16*)(ws + WS_W1T))
#define Wbrt ((bf16*)(ws + WS_WBR))
#define Woutt ((bf16*)(ws + WS_WOUT))
#define Wgut ((bf16*)(ws + WS_WGU))
#define Wdt ((bf16*)(ws + WS_WD))
#define XN ((bf16*)(ws + WS_XN))
#define Qb ((bf16*)(ws + WS_QB))
#define Kb ((bf16*)(ws + WS_KB))
#define Vb ((bf16*)(ws + WS_VB))
#define QMb ((bf16*)(ws + WS_QMB))
#define U ((float*)(ws + WS_U))
#define Gt ((bf16*)(ws + WS_G))
#define MKb ((bf16*)(ws + WS_MKB))
#define MVb ((bf16*)(ws + WS_MVB))
#define BR ((bf16*)(ws + WS_BR))
#define TMP ((float*)(ws + WS_TMP))
#define MG ((bf16*)(ws + WS_MG))
#define X1 ((float*)(ws + WS_X1))
#define A2 ((bf16*)(ws + WS_A2))
#define SS ((float*)(ws + WS_SS))
#define GG ((bf16*)(ws + WS_GG))
#define UU ((bf16*)(ws + WS_UU))
#define ACT ((bf16*)(ws + WS_ACT))
#define X2 ((float*)(ws + WS_X2))
#define PART ((float*)(ws + WS_TMP))
typedef const __attribute__((address_space(4))) unsigned long long* KAP;
#define KA(i) ((void*)ka_l[i])
#define ws ((unsigned char*)KA(34))
#define out ((float*)KA(33))
#define LANE_INIT() do { asm volatile("v_mbcnt_lo_u32_b32 %0, -1, 0\n\tv_mbcnt_hi_u32_b32 %0, -1, %0" : "=v"(lane)); wave = wave_s; tid = wave * 64 + lane; } while (0)
#define PHASE_ARGS() do { ka_l = ka; asm volatile("" : "+s"(ka_l)); LANE_INIT(); gw = vcu * NWAVES + wave; } while (0)
__global__ void __launch_bounds__(NTHR, 2) fwd_kernel(Args args) {
    extern __shared__ __attribute__((aligned(16))) unsigned char lds_raw[];
    LAS unsigned char* lds = (LAS unsigned char*)lds_raw;
    volatile LAS unsigned* MISC = (volatile LAS unsigned*)(lds + MISC_OFF);
    const int wave_s = __builtin_amdgcn_readfirstlane((int)threadIdx.x >> 6);
    int lane, tid, wave; LANE_INIT();
    const int G = gridDim.x; const int bx = blockIdx.x; const int vcu = (G % 8 == 0) ? (bx % 8) * (G / 8) + bx / 8 : bx;
    const KAP ka = (KAP)__builtin_amdgcn_kernarg_segment_ptr();
    KAP ka_l = ka; asm volatile("" : "+s"(ka_l));
    for (int u = tid; u < (LDS_BYTES - LDSCTL_OFF) / 4; u += NTHR) ((LAS unsigned*)(lds + LDSCTL_OFF))[u] = 0u;
    __syncthreads();
    XcdBarrier bar = xcd_barrier_post((unsigned*)(ws + WS_CTL) + CW_BAR, MISC + 8);
    int gw = vcu * NWAVES + wave; const int NGW = G * NWAVES;

    {
        LAS float* scr = (LAS float*)(lds + wave * 16384);
        constexpr int I1 = 16 * 160, I2 = 16 * 16, I3 = 8 * 32, I4 = 4 * 32, I5 = 4 * 32, I6 = 16 * 32, I7 = 16 * 88, I8 = 16 * 88, I9 = 44 * 32;
        constexpr int NITEMS = I1 + I2 + I3 + I4 + I5 + I6 + I7 + I8 + I9;
        for (int it = gw; it < NITEMS; it += NGW) {
            int r = it;
            if (r < I1) { p0_transpose_item(w_in, 5120, W1t, 1024, 0, 0, 0, scr, r, lane); continue; } r -= I1;
            if (r < I2) { p0_transpose_item(w_mem_kv, 512, W1t, 1024, 0, 5120, 0, scr, r, lane); continue; } r -= I2;
            if (r < I3) { p0_transpose_item(w_br_attn, 1024, Wbrt, 1024, 0, 0, 0, scr, r, lane); continue; } r -= I3;
            if (r < I4) { p0_transpose_item(w_br_pool, 1024, Wbrt, 1024, 512, 0, 0, scr, r, lane); continue; } r -= I4;
            if (r < I5) { p0_transpose_item(w_br_mem, 1024, Wbrt, 1024, 768, 0, 0, scr, r, lane); continue; } r -= I5;
            if (r < I6) { p0_transpose_item(w_out, 1024, Woutt, 1024, 0, 0, 0, scr, r, lane); continue; } r -= I6;
            if (r < I7) { p0_transpose_item(w_ffn_gate, DFF, Wgut, 1024, 0, 0, 1, scr, r, lane); continue; } r -= I7;
            if (r < I8) { p0_transpose_item(w_ffn_up, DFF, Wgut, 1024, 0, 0, 2, scr, r, lane); continue; } r -= I8;
            p0_transpose_item(w_ffn_down, 1024, Wdt, DFF, 0, 0, 0, scr, r, lane);
        }
        for (int m = gw; m < MA; m += NGW) {
            const float* src; const float* gain;
            if (m < MP) { src = x_prompt + (size_t)m * D; gain = norm1_g; }
            else if (m < MT) { src = x_sample + (size_t)(m - MP) * D; gain = norm1_g; }
            else { src = mem_prompt + (size_t)(m - MT) * D; gain = mem_norm_g; }
            rms_row_to_bf16(src, gain, XN + (size_t)m * D, lane);
        }
    }
    xcd_barrier(bar); PHASE_ARGS();

    {
        pg8::Gemm g{XN, W1t, 1024, 1024, 1024}; pg8::Order1 S; S.init(G, bx);
        pg8::Epi1 E{Qb, Kb, Vb, QMb, Gt, MKb, MVb, U, out};
        pg8::gemm_phase<pg8::Epi1, pg8::Order1>(lds, g, S, E, tid);
    }
    xcd_barrier(bar); PHASE_ARGS();

    {
        LAS float* T2 = (LAS float*)lds;
        LAS unsigned char* sm = lds + 4096;
        for (int idx = tid; idx < 1024; idx += NTHR) { const int hh = idx >> 8, n = idx & 255;
            int bk = n;
            if (n >= 16) { const float nf = (float)n; int lg = 16 + (int)(logf(nf / 16.f) / 2.0794415416798357f * 16.f); bk = lg < 31 ? lg : 31; }
            T2[idx] = rel_bias[bk * 4 + hh] * LOG2E; }
        const float e1 = wave_sum(lam_q1[lane] * lam_k1[lane]), e2 = wave_sum(lam_q2[lane] * lam_k2[lane]);
        const float lam = expf(e1) - expf(e2) + LAM_INIT;
        __syncthreads();
        const int l16 = lane & 15, g4 = lane >> 4;
        for (int p = vcu; p < 256; p += G) {
            const int bh = p >> 3, s = p & 7, b = bh >> 2, h = bh & 3;
            for (int half = 0; half < 2; ++half) {
                const int qb = half == 0 ? s : 15 - s; const int q0 = 128 * qb; const size_t rb = (size_t)b * SEQ;
                f32x4 O[2][8]; float ls[2];
                flash_unit<2, 128, true>(sm, T2 + h * 256, Qb + (rb + q0) * 512 + h * 128, 512, Kb + rb * 512 + h * 128, 512, Vb + rb * 512 + h * 128, 512,
                                         2 * qb + 2, q0, O, ls, tid, wave, lane);
                const float i0 = 1.f / ls[0], i1 = lam / ls[1];
                float ss = 0.f;
#pragma unroll
                for (int dg = 0; dg < 8; ++dg) { O[0][dg] = O[0][dg] * i0 - O[1][dg] * i1; ss += (O[0][dg][0] * O[0][dg][0] + O[0][dg][1] * O[0][dg][1]) + (O[0][dg][2] * O[0][dg][2] + O[0][dg][3] * O[0][dg][3]); }
                ss = sum_g4(ss);
                const float r = frsq(ss * (1.f / 128.f) + EPS) * (1.f - LAM_INIT);
                bf16* op = BR + (rb + q0 + 16 * wave + l16) * 1024 + h * 128 + 4 * g4;
#pragma unroll
                for (int dg = 0; dg < 8; ++dg) { const f32x4 sg = *(const f32x4*)(subln_g + 16 * dg + 4 * g4); const f32x4 o = O[0][dg] * r * sg;
                    u32x2 w; w.x = pk2(o[0], o[1]); w.y = pk2(o[2], o[3]); *(u32x2*)(op + 16 * dg) = w; }
            }
        }
        for (int it = vcu; it < DB * 4; it += G) {
            const int b = it >> 2, h = it & 3; const size_t r0 = (size_t)MP + (size_t)b * DS;
            decode_item<true>(sm, T2 + h * 256, b, h, cache_k, cache_v, page_table, Qb + r0 * 512 + h * 128, 512, Kb + r0 * 512 + h * 128, Vb + r0 * 512 + h * 128,
                              lam, subln_g, BR + r0 * 1024 + h * 128, tid, wave, lane);
        }
        for (int un = vcu; un < 512; un += G) {
            const int bh = un >> 4, qb = un & 15, b = bh >> 2, h = bh & 3; const size_t rb = (size_t)b * SEQ + 128 * qb;
            f32x4 O[1][4]; float ls[1];
            flash_unit<1, 64, false>(sm, T2, QMb + rb * 256 + h * 64, 256, MKb + (size_t)b * 256 * 256 + h * 64, 256, MVb + (size_t)b * 256 * 256 + h * 64, 256, 4, 0, O, ls, tid, wave, lane);
            const float i0 = 1.f / ls[0];
            bf16* op = BR + (rb + 16 * wave + l16) * 1024 + 768 + h * 64 + 4 * g4;
#pragma unroll
            for (int dg = 0; dg < 4; ++dg) { const f32x4 o = O[0][dg] * i0; u32x2 w; w.x = pk2(o[0], o[1]); w.y = pk2(o[2], o[3]); *(u32x2*)(op + 16 * dg) = w; }
        }
        for (int it = vcu; it < DB * 4; it += G) {
            const int b = it >> 2, h = it & 3; const size_t r0 = (size_t)MP + (size_t)b * DS;
            decode_item<false>(sm, T2, b, h, cache_mem_k, cache_mem_v, page_table, QMb + r0 * 256 + h * 64, 256, nullptr, nullptr, 0.f, subln_g, BR + r0 * 1024 + 768 + h * 64, tid, wave, lane);
        }
        {
            LAS float* E = (LAS float*)sm;
            LAS float* Dt = (LAS float*)(sm + 46 * 1024);
            for (int ti = vcu; ti < MT / 16; ti += G) {
                const bool smp = ti >= MP / 16;
                if (!smp) { const int r0 = 16 * ti, t0 = r0 & (SEQ - 1);
                    for (int idx = tid; idx < 31 * 64; idx += NTHR) { const int j = idx >> 6, c4 = idx & 63; const int t = t0 - 15 + j;
                        f32x4 v = (f32x4){0.f, 0.f, 0.f, 0.f}; if (t >= 0) v = *(const f32x4*)(U + (size_t)(r0 - 15 + j) * 256 + 4 * c4);
                        *(LAS f32x4*)(E + j * 256 + 4 * c4) = v; }
                } else { const int b0 = 2 * (ti - MP / 16);
                    for (int idx = tid; idx < 46 * 64; idx += NTHR) { const int jj = idx >> 6, c4 = idx & 63; const int sq = jj / 23, j = jj % 23; const int b = b0 + sq;
                        const f32x4 v = j < 15 ? *(const f32x4*)(state_pool + ((size_t)b * 15 + j) * 256 + 4 * c4) : *(const f32x4*)(U + ((size_t)MP + (size_t)b * 8 + (j - 15)) * 256 + 4 * c4);
                        *(LAS f32x4*)(E + jj * 256 + 4 * c4) = v; }
                }
                __syncthreads();
                {   const int ch = tid & 255, gi = ch >> 6, w = 2 << gi;
#pragma unroll
                    for (int k = 0; k < 8; ++k) { const int tk = (tid >> 8) + 2 * k;
                        int base, cnt;
                        if (!smp) { base = 15 + tk; const int pos = ((16 * ti) & (SEQ - 1)) + tk; cnt = pos + 1 < w ? pos + 1 : w; }
                        else { base = (tk >> 3) * 23 + 15 + (tk & 7); cnt = w; }
                        float sacc = 0.f;
                        for (int j = 0; j < w; ++j) sacc += E[(base - j) * 256 + ch];
                        Dt[tk * 256 + ch] = sacc / (float)cnt - E[base * 256 + ch]; }
                }
                __syncthreads();
                {   const int och = tid & 255, gi = och >> 6, o = och & 63, th = tid >> 8;
                    float acc[8];
#pragma unroll
                    for (int k = 0; k < 8; ++k) acc[k] = 0.f;
                    const float* wp = w_pool_grp + (size_t)gi * 4096 + o;
                    for (int c = 0; c < 64; c += 4) {
                        const float w0 = wp[(c + 0) * 64], w1 = wp[(c + 1) * 64], w2 = wp[(c + 2) * 64], w3 = wp[(c + 3) * 64];
#pragma unroll
                        for (int k = 0; k < 8; ++k) { const f32x4 dv = *(const LAS f32x4*)(Dt + (8 * th + k) * 256 + gi * 64 + c); acc[k] += dv[0] * w0 + dv[1] * w1 + dv[2] * w2 + dv[3] * w3; }
                    }
                    const float psc = pool_scale[och];
#pragma unroll
                    for (int k = 0; k < 8; ++k) BR[(size_t)(16 * ti + 8 * th + k) * 1024 + 512 + och] = (bf16)(pk2(acc[k] * psc, 0.f) & 0xffffu);
                }
                __syncthreads();
            }
            for (int idx = bx * NTHR + tid; idx < (NB + DB) * 15 * 64; idx += G * NTHR) {
                const int c4 = idx & 63, rj = idx >> 6;
                if (rj < NB * 15) { const int b = rj / 15, j = rj % 15; *(f32x4*)(out + O_POOLP + (size_t)rj * 256 + 4 * c4) = *(const f32x4*)(U + ((size_t)b * SEQ + SEQ - 15 + j) * 256 + 4 * c4); }
                else { const int r2 = rj - NB * 15, b = r2 / 15, j = r2 % 15;
                    const f32x4 v = j < 7 ? *(const f32x4*)(state_pool + ((size_t)b * 15 + 8 + j) * 256 + 4 * c4) : *(const f32x4*)(U + ((size_t)MP + (size_t)b * 8 + (j - 7)) * 256 + 4 * c4);
                    *(f32x4*)(out + O_POOLS + (size_t)r2 * 256 + 4 * c4) = v; }
            }
        }
    }
    xcd_barrier(bar); PHASE_ARGS();

    {
        pg8::Gemm g{BR, Wbrt, 1024, 1024, 1024}; pg8::StaticOrder S; S.init(MT, 1024, G, bx);
        pg8::Epi3 E{Gt, MG};
        pg8::gemm_phase<pg8::Epi3, pg8::StaticOrder>(lds, g, S, E, tid);
    }
    xcd_barrier(bar); PHASE_ARGS();

    {
        pg8::Gemm g{MG, Woutt, 1024, 1024, 1024}; pg8::StaticOrder S; S.init(MT, 1024, G, bx);
        pg8::Epi4 E{x_prompt, x_sample, norm2_g, X1, A2, SS};
        pg8::gemm_phase<pg8::Epi4, pg8::StaticOrder>(lds, g, S, E, tid);
    }
    xcd_barrier(bar); PHASE_ARGS();

    {
        pg8::Gemm g{A2, Wgut, 1024, 1024, 1024}; pg8::StaticOrder S; S.init(MT, NGU, G, bx);
        pg8::Epi5 E{SS, GG, UU, out};
        pg8::gemm_phase<pg8::Epi5, pg8::StaticOrder>(lds, g, S, E, tid);
    }
    xcd_barrier(bar); PHASE_ARGS();

    {
        constexpr int CPR = DFF / 8;
#define UNPK8(dst, V_) do { const u32x4 t_ = (V_); dst[0] = bflo(t_.x); dst[1] = bfhi(t_.x); dst[2] = bflo(t_.y); dst[3] = bfhi(t_.y); dst[4] = bflo(t_.z); dst[5] = bfhi(t_.z); dst[6] = bflo(t_.w); dst[7] = bfhi(t_.w); } while (0)
        for (int idx = bx * NTHR + tid; idx < (MT / 8) * CPR; idx += G * NTHR) {
            const int rb = idx / CPR, ch0 = (idx - rb * CPR) * 8, row0 = rb * 8;
            float cw0[8], cw1[8], cw2[8], cb[8], gm1[8], gm2[8];
#pragma unroll
            for (int e = 0; e < 8; e += 4) { const f32x4 a0 = *(const f32x4*)(conv_w + ch0 + e), a1 = *(const f32x4*)(conv_w + DFF + ch0 + e), a2 = *(const f32x4*)(conv_w + 2 * DFF + ch0 + e), a3 = *(const f32x4*)(conv_b + ch0 + e);
#pragma unroll
                for (int j = 0; j < 4; ++j) { cw0[e + j] = a0[j]; cw1[e + j] = a1[j]; cw2[e + j] = a2[j]; cb[e + j] = a3[j]; } }
            if (row0 < MP) {
                if ((row0 & (SEQ - 1)) != 0) { const u32x4 w1 = *(const u32x4*)(GG + (size_t)(row0 - 1) * DFF + ch0), w2 = *(const u32x4*)(GG + (size_t)(row0 - 2) * DFF + ch0); UNPK8(gm1, w1); UNPK8(gm2, w2); }
                else {
#pragma unroll
                    for (int e = 0; e < 8; ++e) { gm1[e] = 0.f; gm2[e] = 0.f; } }
            } else { const float* sp = state_conv + (size_t)((row0 - MP) >> 3) * 2 * DFF + ch0;
#pragma unroll
                for (int e = 0; e < 8; e += 4) { const f32x4 s0 = *(const f32x4*)(sp + e), s1 = *(const f32x4*)(sp + DFF + e);
#pragma unroll
                    for (int j = 0; j < 4; ++j) { gm2[e + j] = s0[j]; gm1[e + j] = s1[j]; } } }
            u32x4 gw[8], uw[8];
#pragma unroll
            for (int r = 0; r < 8; ++r) { gw[r] = *(const u32x4*)(GG + (size_t)(row0 + r) * DFF + ch0); uw[r] = *(const u32x4*)(UU + (size_t)(row0 + r) * DFF + ch0); }
#pragma unroll
            for (int r = 0; r < 8; ++r) {
                float g0[8], uu[8], a[8]; UNPK8(g0, gw[r]); UNPK8(uu, uw[r]);
#pragma unroll
                for (int e = 0; e < 8; ++e) {
                    const float gc = cb[e] + cw0[e] * gm2[e] + cw1[e] * gm1[e] + cw2[e] * g0[e];
                    const float z = 0.7978845608028654f * (gc + 0.044715f * gc * gc * gc);
                    a[e] = gc * frcp(1.f + fexp2(-2.f * LOG2E * z)) * uu[e];
                    gm2[e] = gm1[e]; gm1[e] = g0[e]; }
                u32x4 w; w.x = pk2(a[0], a[1]); w.y = pk2(a[2], a[3]); w.z = pk2(a[4], a[5]); w.w = pk2(a[6], a[7]);
                *(u32x4*)(ACT + (size_t)(row0 + r) * DFF + ch0) = w;
            }
        }
#undef UNPK8
    }
    xcd_barrier(bar); PHASE_ARGS();

    {
        { pg8::Gemm g{ACT, Wdt, DFF, DFF, DFF}; pg8::StaticOrder S; S.init(MP, 1024, G, bx);
          pg8::Epi6 E{X1, X2};
          pg8::gemm_phase<pg8::Epi6, pg8::StaticOrder>(lds, g, S, E, tid); }
        { pg8::Gemm g{ACT, Wdt, 256, DFF, DFF}; pg8::SplitOrder S; S.init(DFF / 256, 256, G, bx);
          pg8::EpiPart E{PART, 256};
          pg8::gemm_phase<pg8::EpiPart, pg8::SplitOrder>(lds, g, S, E, tid); }
    }
    xcd_barrier(bar); PHASE_ARGS();

    for (int m = gw; m < MT; m += NGW) {
        const f32x4* xr = (const f32x4*)(X2 + (size_t)m * D) + lane; const f32x4* gr = (const f32x4*)final_g + lane;
        f32x4 v[4]; float s = 0.f;
#pragma unroll
        for (int j = 0; j < 4; ++j) v[j] = (f32x4){0.f, 0.f, 0.f, 0.f};
        if (m < MP) {
#pragma unroll
            for (int j = 0; j < 4; ++j) v[j] = xr[64 * j];
        } else {
            const f32x4* x1r = (const f32x4*)(X1 + (size_t)m * D) + lane;
#pragma unroll
            for (int j = 0; j < 4; ++j) v[j] = x1r[64 * j];
            for (int ch = 0; ch < DFF / 256; ++ch) { const f32x4* pr = (const f32x4*)(PART + ((size_t)ch * MS + (size_t)(m - MP)) * D) + lane;
#pragma unroll
                for (int j = 0; j < 4; ++j) v[j] = v[j] + pr[64 * j]; }
        }
#pragma unroll
        for (int j = 0; j < 4; ++j) s += (v[j][0] * v[j][0] + v[j][1] * v[j][1]) + (v[j][2] * v[j][2] + v[j][3] * v[j][3]);
        const float rstd = frsq(wave_sum(s) * (1.f / 1024.f) + EPS);
        f32x4* o = (f32x4*)(out + (m < MP ? O_YP + (size_t)m * D : O_YS + (size_t)(m - MP) * D)) + lane;
#pragma unroll
        for (int j = 0; j < 4; ++j) o[64 * j] = v[j] * rstd * gr[64 * j];
    }
}

#undef ws
#undef out
extern "C" void kernel_launch(void* const* d_in, const int* in_sizes, int n_in, void* d_out, int out_size, void* d_ws, size_t ws_size, hipStream_t stream) {
    static int grid = 0;
    if (grid == 0) {
        if (n_in != 33 || (size_t)out_size != O_END || ws_size < WS_END) { fprintf(stderr, "kernel_launch: unexpected shapes (n_in %d, out %d, ws %zu)\n", n_in, out_size, ws_size); grid = -1; return; }
        int dev = 0, cus = 0;
        if (hipGetDevice(&dev) != hipSuccess || hipDeviceGetAttribute(&cus, hipDeviceAttributeMultiprocessorCount, dev) != hipSuccess) { grid = -1; return; }
        if (hipFuncSetAttribute((const void*)fwd_kernel, hipFuncAttributeMaxDynamicSharedMemorySize, LDS_BYTES) != hipSuccess) { fprintf(stderr, "kernel_launch: hipFuncSetAttribute failed\n"); grid = -1; return; }
        int per_cu = 0;
        if (hipOccupancyMaxActiveBlocksPerMultiprocessor(&per_cu, (const void*)fwd_kernel, NTHR, LDS_BYTES) != hipSuccess || per_cu < 1) fprintf(stderr, "kernel_launch: occupancy query reports %d\n", per_cu);
        (void)hipGetLastError();
        grid = cus;
    }
    if (grid < 0) return;
    if (hipMemsetAsync((char*)d_ws + WS_CTL, 0, CTL_ZERO_BYTES, stream) != hipSuccess) return;
    Args a{};
    for (int i = 0; i < 33; ++i) a.in[i] = d_in[i];
    a.out = (float*)d_out; a.ws = (unsigned char*)d_ws;
    hipLaunchKernelGGL(fwd_kernel, dim3(grid), dim3(NTHR), LDS_BYTES, stream, a);
}
```
